# Optimizing an MI355X kernel written in HIP

```python
import math
import jax, jax.numpy as jnp
from jax import lax
import numpy as np

D_MODEL = 1024
BATCH = 8
SEQ = 2048
DEPTH = 2

HEAD_DIM = 64
ROPE_THETA = 10000.0
NORM_EPS = 1e-6
NEG_INF = -1e30
Q_BLOCK = 128

A_HEADS = 8
A_TOPK_MAX = 256
IDX_HEADS = 8
IDX_DIM = HEAD_DIM
B_HEADS = 4
B_VDIM = 2 * HEAD_DIM
SUBLN_EPS = 1e-5
C_HEADS = D_MODEL // HEAD_DIM
C_PATTERNS = ((128, 1), (512, 4), (2048, 16))
D_FF = ((8 * D_MODEL // 3 + 127) // 128) * 128
PLE_DIM = 256

N_EVEN = (DEPTH + 1) // 2
N_ODD = DEPTH // 2

EVEN_SPLITS = (
    A_HEADS * HEAD_DIM,
    HEAD_DIM,
    HEAD_DIM,
    IDX_HEADS * IDX_DIM,
    IDX_DIM,
    IDX_HEADS,
    2 * B_HEADS * HEAD_DIM,
    2 * B_HEADS * HEAD_DIM,
    B_HEADS * B_VDIM,
)
EVEN_IN = sum(EVEN_SPLITS)
EVEN_MIX_WIDTH = A_HEADS * HEAD_DIM + B_HEADS * B_VDIM

kernel_name = "hybrid_dsa_diff_dilated_macaron"

f32 = jnp.float32


def rms_norm(x, g, eps=NORM_EPS):
    x32 = x.astype(f32)
    y = x32 * lax.rsqrt(jnp.mean(x32 * x32, axis=-1, keepdims=True) + eps)
    return (y * g.astype(f32)).astype(x.dtype)


def rope_tables(T, dim):
    inv = 1.0 / (ROPE_THETA ** (jnp.arange(0, dim, 2, dtype=f32) / dim))
    ang = jnp.arange(T, dtype=f32)[:, None] * inv[None, :]
    return jnp.cos(ang), jnp.sin(ang)


def apply_rope(x, cos, sin):
    shape = (x.shape[1],) + (1,) * (x.ndim - 3) + (cos.shape[-1],)
    c, s = cos.reshape(shape), sin.reshape(shape)
    x1, x2 = jnp.split(x.astype(f32), 2, axis=-1)
    return jnp.concatenate([x1 * c - x2 * s, x2 * c + x1 * s], axis=-1).astype(x.dtype)


def swiglu(h, wg, wu, wd):
    return (jax.nn.silu(h @ wg) * (h @ wu)) @ wd


def to_query_blocks(a):
    B, T = a.shape[:2]
    a = a.reshape((B, T // Q_BLOCK, Q_BLOCK) + a.shape[2:])
    return jnp.moveaxis(a, 1, 0)


def from_query_blocks(a):
    a = jnp.moveaxis(a, 0, 1)
    return a.reshape((a.shape[0], a.shape[1] * a.shape[2]) + a.shape[3:])


def dsa_attention(q, k, v, q_idx, k_idx, w_idx, top_k):
    T = q.shape[1]
    scale = HEAD_DIM ** -0.5
    idx_scale = (IDX_DIM ** -0.5) * (IDX_HEADS ** -0.5)
    k_idx32 = k_idx.astype(f32)
    key_pos = jnp.arange(T)
    gather = jax.vmap(lambda a, i: a[i])

    def block(args):
        qb, qib, wb, start = args
        qpos = start + jnp.arange(Q_BLOCK)
        causal = key_pos[None, :] <= qpos[:, None]
        rel = jax.nn.relu(jnp.einsum('bqhd,bsd->bqhs', qib.astype(f32), k_idx32))
        iscore = jnp.einsum('bqhs,bqh->bqs', rel, wb.astype(f32)) * idx_scale
        iscore = jnp.where(causal[None], iscore, NEG_INF)
        _, sel = lax.top_k(iscore, top_k)
        ks = gather(k, sel)
        vs = gather(v, sel)
        s = jnp.einsum('bqhd,bqkd->bqhk', qb, ks).astype(f32) * scale
        valid = (sel <= qpos[None, :, None])[:, :, None, :]
        pr = jax.nn.softmax(jnp.where(valid, s, NEG_INF), axis=-1)
        return jnp.einsum('bqhk,bqkd->bqhd', pr.astype(vs.dtype), vs)

    starts = jnp.arange(T // Q_BLOCK) * Q_BLOCK
    out = lax.map(block, (to_query_blocks(q), to_query_blocks(q_idx), to_query_blocks(w_idx), starts))
    return from_query_blocks(out)


def diff_attention(q1, q2, k1, k2, v, lam):
    T = q1.shape[1]
    scale = HEAD_DIM ** -0.5
    key_pos = jnp.arange(T)

    def block(args):
        q1b, q2b, start = args
        qpos = start + jnp.arange(Q_BLOCK)
        causal = (key_pos[None, :] <= qpos[:, None])[None, None]

        def probs(qb, kk):
            s = jnp.einsum('bqhd,bshd->bhqs', qb, kk).astype(f32) * scale
            return jax.nn.softmax(jnp.where(causal, s, NEG_INF), axis=-1)

        a = probs(q1b, k1) - lam * probs(q2b, k2)
        return jnp.einsum('bhqs,bshe->bqhe', a.astype(v.dtype), v)

    starts = jnp.arange(T // Q_BLOCK) * Q_BLOCK
    out = lax.map(block, (to_query_blocks(q1), to_query_blocks(q2), starts))
    return from_query_blocks(out)


def dilated_branch(q, k, v, window, dilation):
    B, T, H, D = q.shape
    span = window // dilation
    n = T // dilation
    nb = -(-n // span)
    n_pad = nb * span
    Z = B * dilation

    def to_sub(a):
        E = a.shape[-1]
        a = a.reshape(B, n, dilation, H, E).transpose(0, 2, 1, 3, 4).reshape(Z, n, H, E)
        return jnp.pad(a, ((0, 0), (0, n_pad - n), (0, 0), (0, 0)))

    def banded(a):
        E = a.shape[-1]
        a = jnp.pad(a, ((0, 0), (span, 0), (0, 0), (0, 0))).reshape(Z, nb + 1, span, H, E)
        return jnp.concatenate([a[:, :-1], a[:, 1:]], axis=2)

    qb = to_sub(q).reshape(Z, nb, span, H, D)
    kb = banded(to_sub(k))
    vb = banded(to_sub(v))
    dist = jnp.arange(span)[:, None] + span - jnp.arange(2 * span)[None, :]
    m_key = jnp.arange(nb)[:, None] * span + jnp.arange(2 * span)[None, :] - span
    mask = ((dist >= 0) & (dist <= span))[None] & ((m_key >= 0) & (m_key < n))[:, None, :]
    s = jnp.einsum('znqhd,znkhd->znhqk', qb, kb).astype(f32) * (HEAD_DIM ** -0.5)
    s = jnp.where(mask[None, :, None], s, NEG_INF)
    lse = jax.nn.logsumexp(s, axis=-1)
    pr = jnp.exp(s - lse[..., None])
    o = jnp.einsum('znhqk,znkhd->znqhd', pr.astype(v.dtype), vb)

    def from_sub(a):
        a = a.reshape((B, dilation, n_pad) + a.shape[3:])[:, :, :n]
        a = jnp.moveaxis(a, 1, 2)
        return a.reshape((B, T) + a.shape[3:])

    return from_sub(o), from_sub(jnp.moveaxis(lse, 2, 3))


def dilated_mixture(q, k, v):
    outs, lses = [], []
    for window, dilation in C_PATTERNS:
        o, l = dilated_branch(q, k, v, window, dilation)
        outs.append(o)
        lses.append(l)
    alpha = jax.nn.softmax(jnp.stack(lses, 0), axis=0)
    return jnp.sum(alpha[..., None].astype(q.dtype) * jnp.stack(outs, 0), axis=0)


def even_mixer(h, w_in, w_out, lq1, lk1, lq2, lk2, subln, lambda_init, cos, sin, top_k):
    B, T, _ = h.shape
    cuts = [int(c) for c in np.cumsum(EVEN_SPLITS)[:-1]]
    qa, ka, va, qi, ki, wi, qb, kb, vb = jnp.split(h @ w_in, cuts, axis=-1)
    qa = apply_rope(qa.reshape(B, T, A_HEADS, HEAD_DIM), cos, sin)
    ka = apply_rope(ka, cos, sin)
    qi = apply_rope(qi.reshape(B, T, IDX_HEADS, IDX_DIM), cos, sin)
    ki = apply_rope(ki, cos, sin)
    out_a = dsa_attention(qa, ka, va, qi, ki, wi, top_k).reshape(B, T, A_HEADS * HEAD_DIM)
    qb = apply_rope(qb.reshape(B, T, 2 * B_HEADS, HEAD_DIM), cos, sin).reshape(B, T, B_HEADS, 2, HEAD_DIM)
    kb = apply_rope(kb.reshape(B, T, 2 * B_HEADS, HEAD_DIM), cos, sin).reshape(B, T, B_HEADS, 2, HEAD_DIM)
    vb = vb.reshape(B, T, B_HEADS, B_VDIM)
    lam = (jnp.exp(jnp.sum(lq1.astype(f32) * lk1.astype(f32)))
           - jnp.exp(jnp.sum(lq2.astype(f32) * lk2.astype(f32))) + lambda_init)
    ob = diff_attention(qb[..., 0, :], qb[..., 1, :], kb[..., 0, :], kb[..., 1, :], vb, lam)
    ob = rms_norm(ob, subln, SUBLN_EPS) * (1.0 - lambda_init)
    merged = jnp.concatenate([out_a, ob.reshape(B, T, B_HEADS * B_VDIM)], axis=-1)
    return merged @ w_out


def odd_mixer(h, w_in, w_out, cos, sin):
    B, T, _ = h.shape
    q, k, v = jnp.split(h @ w_in, 3, axis=-1)
    q = apply_rope(q.reshape(B, T, C_HEADS, HEAD_DIM), cos, sin)
    k = apply_rope(k.reshape(B, T, C_HEADS, HEAD_DIM), cos, sin)
    v = v.reshape(B, T, C_HEADS, HEAD_DIM)
    return dilated_mixture(q, k, v).reshape(B, T, C_HEADS * HEAD_DIM) @ w_out


def setup_inputs(seed: int = 0) -> dict:
    key = jax.random.key(seed)
    ks = iter(jax.random.split(key, 32))

    def w(shape, fan_in):
        return jax.random.normal(next(ks), shape, f32) * (fan_in ** -0.5)

    def gain(shape):
        return 1.0 + 0.02 * jax.random.normal(next(ks), shape, f32)

    return {
        "x": jax.random.normal(next(ks), (BATCH, SEQ, D_MODEL), f32),
        "p": jax.random.normal(next(ks), (DEPTH, BATCH, SEQ, PLE_DIM), f32),
        "norm_ffn_a": gain((DEPTH, D_MODEL)),
        "ffn_a_wg": w((DEPTH, D_MODEL, D_FF), D_MODEL),
        "ffn_a_wu": w((DEPTH, D_MODEL, D_FF), D_MODEL),
        "ffn_a_wd": w((DEPTH, D_FF, D_MODEL), D_FF),
        "norm_mix": gain((DEPTH, D_MODEL)),
        "norm_ffn_b": gain((DEPTH, D_MODEL)),
        "ffn_b_wg": w((DEPTH, D_MODEL, D_FF), D_MODEL),
        "ffn_b_wu": w((DEPTH, D_MODEL, D_FF), D_MODEL),
        "ffn_b_wd": w((DEPTH, D_FF, D_MODEL), D_FF),
        "norm_ple": gain((DEPTH, D_MODEL)),
        "ple_gate": w((DEPTH, D_MODEL, D_MODEL), D_MODEL),
        "ple_proj": w((DEPTH, PLE_DIM, D_MODEL), PLE_DIM),
        "even_w_in": w((N_EVEN, D_MODEL, EVEN_IN), D_MODEL),
        "even_w_out": w((N_EVEN, EVEN_MIX_WIDTH, D_MODEL), EVEN_MIX_WIDTH),
        "diff_lambda_q1": 0.1 * jax.random.normal(next(ks), (N_EVEN, HEAD_DIM), f32),
        "diff_lambda_k1": 0.1 * jax.random.normal(next(ks), (N_EVEN, HEAD_DIM), f32),
        "diff_lambda_q2": 0.1 * jax.random.normal(next(ks), (N_EVEN, HEAD_DIM), f32),
        "diff_lambda_k2": 0.1 * jax.random.normal(next(ks), (N_EVEN, HEAD_DIM), f32),
        "diff_subln": gain((N_EVEN, B_VDIM)),
        "odd_w_in": w((N_ODD, D_MODEL, 3 * C_HEADS * HEAD_DIM), D_MODEL),
        "odd_w_out": w((N_ODD, C_HEADS * HEAD_DIM, D_MODEL), C_HEADS * HEAD_DIM),
        "final_norm": gain((D_MODEL,)),
    }


def reference(x, p, norm_ffn_a, ffn_a_wg, ffn_a_wu, ffn_a_wd, norm_mix, norm_ffn_b,
              ffn_b_wg, ffn_b_wu, ffn_b_wd, norm_ple, ple_gate, ple_proj, even_w_in,
              even_w_out, diff_lambda_q1, diff_lambda_k1, diff_lambda_q2, diff_lambda_k2,
              diff_subln, odd_w_in, odd_w_out, final_norm):
    T = x.shape[1]
    top_k = min(A_TOPK_MAX, T // 4)
    cos, sin = rope_tables(T, HEAD_DIM)
    h = x
    for i in range(DEPTH):
        h = h + 0.5 * swiglu(rms_norm(h, norm_ffn_a[i]), ffn_a_wg[i], ffn_a_wu[i], ffn_a_wd[i])
        hn = rms_norm(h, norm_mix[i])
        if i % 2 == 0:
            e = i // 2
            lambda_init = 0.8 - 0.6 * math.exp(-0.3 * i)
            mix = even_mixer(hn, even_w_in[e], even_w_out[e], diff_lambda_q1[e], diff_lambda_k1[e],
                             diff_lambda_q2[e], diff_lambda_k2[e], diff_subln[e], lambda_init,
                             cos, sin, top_k)
        else:
            o = i // 2
            mix = odd_mixer(hn, odd_w_in[o], odd_w_out[o], cos, sin)
        h = h + mix
        h = h + 0.5 * swiglu(rms_norm(h, norm_ffn_b[i]), ffn_b_wg[i], ffn_b_wu[i], ffn_b_wd[i])
        gate = jax.nn.sigmoid(rms_norm(h, norm_ple[i]) @ ple_gate[i])
        h = h + gate * (p[i] @ ple_proj[i])
    return rms_norm(h, final_norm)
```

```cpp
#include <hip/hip_runtime.h>
#include <hip/hip_cooperative_groups.h>
#include <cstdio>
#include <cstdint>
namespace cg = cooperative_groups;
namespace pg8 {
#define PG8_LAS __attribute__((address_space(3)))
typedef unsigned short bf16_t;
typedef short bf16x8 __attribute__((ext_vector_type(8)));
typedef float f32x4 __attribute__((ext_vector_type(4)));
typedef unsigned u32x4 __attribute__((ext_vector_type(4)));
constexpr int BM = 256, BK = 64, HALF = 128, HTB = HALF * BK * 2  , STAGE_BYTES = 8 * HTB, NXCD = 8, WGM = 8;

__host__ __device__ __forceinline__ int lds_byte(int r, int c) { const int st = (r >> 4) * 2 + (c >> 5), rr = r & 15, cc = c & 31, ob = rr * 64 + cc * 2; return st * 1024 + (ob ^ (((ob >> 9) & 1) << 5)); }
__host__ __device__ __forceinline__ void stage_rc(int b, int& R, int& C) { const int st = b / 1024, sb = b % 1024, swz = sb ^ (((sb >> 9) & 1) << 5); R = (st >> 1) * 16 + swz / 64; C = (st & 1) * 32 + (swz % 64) / 2; }
__host__ __device__ __forceinline__ int perm32(int rho) { const int n = rho >> 4, i = rho & 15; return 8 * (i >> 2) + 4 * n + (i & 3); }

struct Unit { int pm, pn; };
struct Gemm { const bf16_t* A; const bf16_t* Bt; int M, N, K; };

struct StaticOrder {
    int nM, nN, nwg, G, c;
    __host__ __device__ void init(int M, int N, int G_, int c_) { nM = M / BM; nN = N / BM; nwg = nM * nN; G = G_; c = c_; }
    __host__ __device__ bool next(int i, Unit& u) const {
        const long L = (long)i * G + c; if (L >= nwg) return false;
        int wgid = (int)L; { const int q = nwg / NXCD, r = nwg % NXCD, xcd = wgid % NXCD, off = wgid / NXCD; wgid = (xcd < r ? xcd * (q + 1) : r * (q + 1) + (xcd - r) * q) + off; }
        const int nig = WGM * nN, gid = wgid / nig, fm = gid * WGM, gsz = (nM - fm) < WGM ? (nM - fm) : WGM;
        u.pm = fm + ((wgid % nig) % gsz); u.pn = (wgid % nig) / gsz; return true;
    }
    __device__ __forceinline__ void a_ready(const Unit&) const {}
    __device__ __forceinline__ void done(const Unit&) const {}
};

__device__ __forceinline__ unsigned cvt_pk_bf16(float lo, float hi) { unsigned r; asm volatile("v_cvt_pk_bf16_f32 %0, %1, %2" : "=v"(r) : "v"(lo), "v"(hi)); return r; }
typedef unsigned u32x2 __attribute__((ext_vector_type(2)));
constexpr float RMS_EPS = 1e-6f, LOG2E = 1.4426950408889634f, C2S = 0.125f * 1.4426950408889634f;
typedef unsigned long long ssq_t;
constexpr float SSQ_SCALE = 1048576.0f, SSQ_INV = 1.0f / (1048576.0f * 1024.0f);
__device__ __forceinline__ float rinv_of(const ssq_t* ssq, int row) { return rsqrtf((float)ssq[row] * SSQ_INV + RMS_EPS); }
__device__ __forceinline__ void ssq_add(ssq_t* p, float v) { atomicAdd(p, (ssq_t)__float2ull_rn(v * SSQ_SCALE)); }
__device__ __forceinline__ float bf2f(unsigned short b) { return __uint_as_float(((unsigned)b) << 16); }

struct EpiSwiglu { static constexpr bool PERM = true, AFTER_DRAIN = false;
    bf16_t* O; const ssq_t* ssq;
    __device__ __forceinline__ void operator()(const f32x4 (&acc)[2][2][4][2], const Unit& u, int wr, int wc, int fr, int fq) const {
        const int row0 = u.pm * BM + wr * 64 + fr, col0 = u.pn * 128 + wc * 32 + 8 * fq;
#pragma unroll
        for (int ai = 0; ai < 2; ++ai)
#pragma unroll
            for (int m = 0; m < 4; ++m) { const int row = row0 + ai * HALF + m * 16; const float ri = rinv_of(ssq, row); float o[8];
#pragma unroll
                for (int n = 0; n < 2; ++n)
#pragma unroll
                    for (int j = 0; j < 4; ++j) { const float g = acc[ai][0][m][n][j] * ri, up = acc[ai][1][m][n][j] * ri;
                        o[n * 4 + j] = g * up * __builtin_amdgcn_rcpf(1.0f + __builtin_amdgcn_exp2f(-LOG2E * g)); }
                u32x4 w; w.x = cvt_pk_bf16(o[0], o[1]); w.y = cvt_pk_bf16(o[2], o[3]); w.z = cvt_pk_bf16(o[4], o[5]); w.w = cvt_pk_bf16(o[6], o[7]);
                *(u32x4*)(O + (size_t)row * 2816 + col0) = w; }
    }
};
struct EpiResid { static constexpr bool PERM = false, AFTER_DRAIN = false;
    const float* hin; float* h; bf16_t* hb; ssq_t* ssq_out; float sc;
    __device__ __forceinline__ void operator()(const f32x4 (&acc)[2][2][4][2], const Unit& u, int wr, int wc, int fr, int fq) const {
        const int row0 = u.pm * BM + wr * 64 + fr, col0 = u.pn * BM + wc * 32 + 4 * fq;
#pragma unroll
        for (int ai = 0; ai < 2; ++ai)
#pragma unroll
            for (int m = 0; m < 4; ++m) { const int row = row0 + ai * HALF + m * 16; float ss = 0.f;
#pragma unroll
                for (int bj = 0; bj < 2; ++bj)
#pragma unroll
                    for (int n = 0; n < 2; ++n) { const size_t off = (size_t)row * 1024 + col0 + bj * HALF + n * 16;
                        f32x4 o = *(const f32x4*)(hin + off) + acc[ai][bj][m][n] * sc; *(f32x4*)(h + off) = o;
                        u32x2 w; w.x = cvt_pk_bf16(o[0], o[1]); w.y = cvt_pk_bf16(o[2], o[3]); *(u32x2*)(hb + off) = w;
                        ss += (o[0] * o[0] + o[1] * o[1]) + (o[2] * o[2] + o[3] * o[3]); }
                ss += __shfl_xor(ss, 16); ss += __shfl_xor(ss, 32);
                if (fq == 0) ssq_add(ssq_out + row, ss);
                asm volatile("" ::: "memory"); }
    }
};
struct EpiPle { static constexpr bool PERM = false, AFTER_DRAIN = false;
    float* h; bf16_t* hb; const bf16_t* pp; const ssq_t* ssq_in; ssq_t* ssq_out;
    __device__ __forceinline__ void operator()(const f32x4 (&acc)[2][2][4][2], const Unit& u, int wr, int wc, int fr, int fq) const {
        const int row0 = u.pm * BM + wr * 64 + fr, col0 = u.pn * BM + wc * 32 + 4 * fq;
#pragma unroll
        for (int ai = 0; ai < 2; ++ai)
#pragma unroll
            for (int m = 0; m < 4; ++m) { const int row = row0 + ai * HALF + m * 16; const float ri = rinv_of(ssq_in, row); float ss = 0.f;
#pragma unroll
                for (int bj = 0; bj < 2; ++bj)
#pragma unroll
                    for (int n = 0; n < 2; ++n) { const size_t off = (size_t)row * 1024 + col0 + bj * HALF + n * 16;
                        const f32x4 hv = *(const f32x4*)(h + off); const u32x2 pv = *(const u32x2*)(pp + off); f32x4 o;
                        const float p0 = __uint_as_float(pv.x << 16), p1 = __uint_as_float(pv.x & 0xffff0000u), p2 = __uint_as_float(pv.y << 16), p3 = __uint_as_float(pv.y & 0xffff0000u);
                        const f32x4 g = acc[ai][bj][m][n] * ri;
                        o[0] = hv[0] + p0 * __builtin_amdgcn_rcpf(1.0f + __builtin_amdgcn_exp2f(-LOG2E * g[0]));
                        o[1] = hv[1] + p1 * __builtin_amdgcn_rcpf(1.0f + __builtin_amdgcn_exp2f(-LOG2E * g[1]));
                        o[2] = hv[2] + p2 * __builtin_amdgcn_rcpf(1.0f + __builtin_amdgcn_exp2f(-LOG2E * g[2]));
                        o[3] = hv[3] + p3 * __builtin_amdgcn_rcpf(1.0f + __builtin_amdgcn_exp2f(-LOG2E * g[3]));
                        *(f32x4*)(h + off) = o;
                        u32x2 w; w.x = cvt_pk_bf16(o[0], o[1]); w.y = cvt_pk_bf16(o[2], o[3]); *(u32x2*)(hb + off) = w;
                        ss += (o[0] * o[0] + o[1] * o[1]) + (o[2] * o[2] + o[3] * o[3]); }
                ss += __shfl_xor(ss, 16); ss += __shfl_xor(ss, 32);
                if (fq == 0) ssq_add(ssq_out + row, ss);
                asm volatile("" ::: "memory"); }
    }
};
struct EpiPlain { static constexpr bool PERM = true, AFTER_DRAIN = false;
    bf16_t* O; int ldo;
    __device__ __forceinline__ void operator()(const f32x4 (&acc)[2][2][4][2], const Unit& u, int wr, int wc, int fr, int fq) const {
        const int row0 = u.pm * BM + wr * 64 + fr, col0 = u.pn * BM + wc * 32 + 8 * fq;
#pragma unroll
        for (int ai = 0; ai < 2; ++ai)
#pragma unroll
            for (int m = 0; m < 4; ++m) { bf16_t* rowp = O + (size_t)(row0 + ai * HALF + m * 16) * ldo + col0;
#pragma unroll
                for (int bj = 0; bj < 2; ++bj) { const f32x4 v0 = acc[ai][bj][m][0], v1 = acc[ai][bj][m][1];
                    u32x4 w; w.x = cvt_pk_bf16(v0[0], v0[1]); w.y = cvt_pk_bf16(v0[2], v0[3]); w.z = cvt_pk_bf16(v1[0], v1[1]); w.w = cvt_pk_bf16(v1[2], v1[3]);
                    *(u32x4*)(rowp + bj * HALF) = w; } }
    }
};
struct EpiProj { static constexpr bool PERM = true, AFTER_DRAIN = false;
    bf16_t* O; int ldo; const ssq_t* ssq; const float* cs; const float* sn; unsigned long long ropemask, sclmask;
    __device__ __forceinline__ void operator()(const f32x4 (&acc)[2][2][4][2], const Unit& u, int wr, int wc, int fr, int fq) const {
        const int G = 4 * u.pn + wc; const bool rope = (ropemask >> G) & 1ull; const float scl = ((sclmask >> G) & 1ull) ? C2S : 1.0f;
        const int row0 = u.pm * BM + wr * 64 + fr, ocol = u.pn * BM + wc * 64 + 8 * fq;
#pragma unroll
        for (int ai = 0; ai < 2; ++ai)
#pragma unroll
            for (int m = 0; m < 4; ++m) { const int row = row0 + ai * HALF + m * 16; const float ri = rinv_of(ssq, row) * scl; const int pos = row & 2047;
                f32x4 a0 = acc[ai][0][m][0] * ri, a1 = acc[ai][0][m][1] * ri, b0 = acc[ai][1][m][0] * ri, b1 = acc[ai][1][m][1] * ri;
                if (rope) { const f32x4 c0 = *(const f32x4*)(cs + pos * 32 + 8 * fq), c1 = *(const f32x4*)(cs + pos * 32 + 8 * fq + 4);
                    const f32x4 s0 = *(const f32x4*)(sn + pos * 32 + 8 * fq), s1 = *(const f32x4*)(sn + pos * 32 + 8 * fq + 4);
                    const f32x4 na0 = a0 * c0 - b0 * s0, na1 = a1 * c1 - b1 * s1, nb0 = b0 * c0 + a0 * s0, nb1 = b1 * c1 + a1 * s1; a0 = na0; a1 = na1; b0 = nb0; b1 = nb1; }
                u32x4 w; w.x = cvt_pk_bf16(a0[0], a0[1]); w.y = cvt_pk_bf16(a0[2], a0[3]); w.z = cvt_pk_bf16(a1[0], a1[1]); w.w = cvt_pk_bf16(a1[2], a1[3]);
                *(u32x4*)(O + (size_t)row * ldo + ocol) = w;
                w.x = cvt_pk_bf16(b0[0], b0[1]); w.y = cvt_pk_bf16(b0[2], b0[3]); w.z = cvt_pk_bf16(b1[0], b1[1]); w.w = cvt_pk_bf16(b1[2], b1[3]);
                *(u32x4*)(O + (size_t)row * ldo + ocol + 32) = w; }
    }
};
template <class Epi, class Sched, bool ALIGN_EPI = false, bool SP2 = false>
__device__ __forceinline__ void gemm_phase(PG8_LAS unsigned char* lds, const Gemm g, const Sched& S, const Epi& E) {
    int tid_ = threadIdx.x; asm volatile("" : "+v"(tid_)); const int tid = tid_, wid = __builtin_amdgcn_readfirstlane(tid >> 6), lane = tid & 63, wr = wid >> 2, wc = wid & 3, fr = lane & 15, fq = lane >> 4;
    const int K = g.K, nt = K / BK;
    unsigned voffA[2], voffB[2];
#pragma unroll
    for (int i = 0; i < 2; ++i) { int R, C; stage_rc(tid * 16 + i * 8192, R, C); const int Rb = Epi::PERM ? ((R & ~31) + perm32(R & 31)) : R;
        voffA[i] = (unsigned)(R * K + C) * 2u; voffB[i] = (unsigned)(Rb * K + C) * 2u; }
    const size_t kstep = (size_t)(BK * 2);
    const size_t hstep = (size_t)HALF * K * 2;
    const size_t tstep = 2 * hstep;
    const unsigned ldsw = (unsigned)wid * 1024u;
    const int aoff = lds_byte(wr * 64 + fr, fq * 8), boff = lds_byte(wc * 32 + fr, fq * 8);
#define PG8_SA(b, h) (((b) * 2 + (h)) * HTB)
#define PG8_SB(b, h) ((4 + (b) * 2 + (h)) * HTB)
#define PG8_STAGE(bufoff, gbase, voff) do { _Pragma("unroll") for (int _i = 0; _i < 2; ++_i) \
        __builtin_amdgcn_global_load_lds((const unsigned*)((const char*)(gbase) + (voff)[_i]), (PG8_LAS unsigned*)(lds + (bufoff) + ldsw + _i * 8192), 16, 0, 0); } while (0)
#define PG8_LDA(dst, b, h) do { _Pragma("unroll") for (int m = 0; m < 4; ++m) _Pragma("unroll") for (int k = 0; k < 2; ++k) dst[m][k] = *(const PG8_LAS bf16x8*)(lds + PG8_SA(b, h) + aoff + m * 2048 + k * 1024); } while (0)
#define PG8_LDB(dst, b, h) do { _Pragma("unroll") for (int n = 0; n < 2; ++n) _Pragma("unroll") for (int k = 0; k < 2; ++k) dst[n][k] = *(const PG8_LAS bf16x8*)(lds + PG8_SB(b, h) + boff + n * 2048 + k * 1024); } while (0)
#define PG8_MMA(ai, bj, At, Bt) do { __builtin_amdgcn_s_setprio(1); _Pragma("unroll") for (int m = 0; m < 4; ++m) _Pragma("unroll") for (int n = 0; n < 2; ++n) _Pragma("unroll") for (int k = 0; k < 2; ++k) \
        acc[ai][bj][m][n] = __builtin_amdgcn_mfma_f32_16x16x32_bf16(Bt[n][k], At[m][k], acc[ai][bj][m][n], 0, 0, 0); __builtin_amdgcn_s_setprio(0); } while (0)
#define PG8_WAIT_V(n) asm volatile("s_waitcnt vmcnt(" #n ")" ::: "memory")
#define PG8_WAIT_L(n) asm volatile("s_waitcnt lgkmcnt(" #n ")" ::: "memory")
#define PG8_BAR __builtin_amdgcn_s_barrier()
#define PG8_SCHED __builtin_amdgcn_sched_barrier(0)
    Unit cur, nxt; int ui = 0;
    if (!S.next(0, cur)) return;
    f32x4 acc[2][2][4][2];
#pragma unroll
    for (int a = 0; a < 2; ++a)
#pragma unroll
        for (int b = 0; b < 2; ++b)
#pragma unroll
            for (int m = 0; m < 4; ++m)
#pragma unroll
                for (int n = 0; n < 2; ++n) acc[a][b][m][n] = (f32x4){0.f, 0.f, 0.f, 0.f};
    bf16x8 At[4][2], B0[2][2], B1[2][2];
    const char* cA = (const char*)g.A + (size_t)cur.pm * tstep; const char* cB = (const char*)g.Bt + (size_t)cur.pn * tstep;
    S.a_ready(cur);
    if constexpr (SP2) {
        PG8_STAGE(PG8_SB(0, 0), cB, voffB); PG8_STAGE(PG8_SB(0, 1), cB + hstep, voffB); PG8_STAGE(PG8_SA(0, 0), cA, voffA); PG8_STAGE(PG8_SA(0, 1), cA + hstep, voffA);
        if (wr == 1) PG8_BAR;
        PG8_WAIT_V(2); PG8_BAR;
        PG8_STAGE(PG8_SB(1, 0), cB + kstep, voffB); PG8_STAGE(PG8_SA(1, 0), cA + kstep, voffA); PG8_STAGE(PG8_SB(1, 1), cB + hstep + kstep, voffB);
        PG8_WAIT_V(6); PG8_BAR;
    } else {
        PG8_STAGE(PG8_SB(0, 0), cB, voffB); PG8_STAGE(PG8_SA(0, 0), cA, voffA); PG8_STAGE(PG8_SB(0, 1), cB + hstep, voffB); PG8_STAGE(PG8_SA(0, 1), cA + hstep, voffA);
        if (wr == 1) PG8_BAR;
        PG8_WAIT_V(4); PG8_BAR;
        PG8_STAGE(PG8_SB(1, 0), cB + kstep, voffB); PG8_STAGE(PG8_SA(1, 0), cA + kstep, voffA); PG8_STAGE(PG8_SB(1, 1), cB + hstep + kstep, voffB);
        PG8_WAIT_V(6); PG8_BAR;
    }
    for (;;) {
        const bool has_next = S.next(ui + 1, nxt);
        const char* nA = has_next ? (const char*)g.A + (size_t)nxt.pm * tstep : cA; const char* nB = has_next ? (const char*)g.Bt + (size_t)nxt.pn * tstep : cB;
        for (int t = 0; t < nt; t += 2) {
            const bool last = (t == nt - 2);
            const char* a1 = cA + (size_t)(t + 1) * kstep;
            const char* a2 = last ? nA : cA + (size_t)(t + 2) * kstep; const char* b2 = last ? nB : cB + (size_t)(t + 2) * kstep;
            const char* a3 = a2 + kstep; const char* b3 = b2 + kstep;
            if (last && has_next) S.a_ready(nxt);
            if constexpr (SP2) {
            PG8_LDB(B0, 0, 0); PG8_LDB(B1, 0, 1); PG8_SCHED; PG8_LDA(At, 0, 0); PG8_STAGE(PG8_SA(1, 1), a1 + hstep, voffA);
            PG8_WAIT_V(8); PG8_WAIT_L(0); PG8_BAR; PG8_MMA(0, 0, At, B0); PG8_MMA(0, 1, At, B1); PG8_BAR; PG8_SCHED;
            PG8_LDA(At, 0, 1); PG8_STAGE(PG8_SB(0, 0), b2, voffB); PG8_STAGE(PG8_SB(0, 1), b2 + hstep, voffB); PG8_STAGE(PG8_SA(0, 0), a2, voffA);
            PG8_WAIT_V(8); PG8_WAIT_L(0); PG8_BAR; PG8_MMA(1, 0, At, B0); PG8_MMA(1, 1, At, B1); PG8_BAR; PG8_SCHED;
            PG8_LDB(B0, 1, 0); PG8_LDB(B1, 1, 1); PG8_SCHED; PG8_LDA(At, 1, 0); PG8_STAGE(PG8_SA(0, 1), a2 + hstep, voffA);
            PG8_WAIT_V(8); PG8_WAIT_L(0); PG8_BAR; PG8_MMA(0, 0, At, B0); PG8_MMA(0, 1, At, B1); PG8_BAR; PG8_SCHED;
            PG8_LDA(At, 1, 1); PG8_STAGE(PG8_SB(1, 0), b3, voffB); PG8_STAGE(PG8_SB(1, 1), b3 + hstep, voffB); PG8_STAGE(PG8_SA(1, 0), a3, voffA);
            PG8_WAIT_V(8); PG8_WAIT_L(0); PG8_BAR; PG8_MMA(1, 0, At, B0); PG8_MMA(1, 1, At, B1); PG8_BAR; PG8_SCHED;
            } else {
            PG8_LDB(B0, 0, 0); PG8_SCHED; PG8_LDA(At, 0, 0); PG8_STAGE(PG8_SA(1, 1), a1 + hstep, voffA);
            PG8_WAIT_L(8); PG8_BAR; PG8_WAIT_L(0); PG8_MMA(0, 0, At, B0); PG8_BAR; PG8_SCHED;
            PG8_LDB(B1, 0, 1); PG8_STAGE(PG8_SB(0, 0), b2, voffB);
            PG8_BAR; PG8_WAIT_L(0); PG8_MMA(0, 1, At, B1); PG8_BAR;
            PG8_LDA(At, 0, 1); PG8_STAGE(PG8_SA(0, 0), a2, voffA);
            PG8_BAR; PG8_WAIT_L(0); PG8_MMA(1, 0, At, B0); PG8_BAR; PG8_SCHED;
            PG8_STAGE(PG8_SB(0, 1), b2 + hstep, voffB);
            PG8_WAIT_V(6); PG8_BAR; PG8_MMA(1, 1, At, B1); PG8_BAR;
            PG8_LDB(B0, 1, 0); PG8_SCHED; PG8_LDA(At, 1, 0); PG8_STAGE(PG8_SA(0, 1), a2 + hstep, voffA);
            PG8_WAIT_L(8); PG8_BAR; PG8_WAIT_L(0); PG8_MMA(0, 0, At, B0); PG8_BAR; PG8_SCHED;
            PG8_LDB(B1, 1, 1); PG8_STAGE(PG8_SB(1, 0), b3, voffB);
            PG8_BAR; PG8_WAIT_L(0); PG8_MMA(0, 1, At, B1); PG8_BAR;
            PG8_LDA(At, 1, 1); PG8_STAGE(PG8_SA(1, 0), a3, voffA);
            PG8_BAR; PG8_WAIT_L(0); PG8_MMA(1, 0, At, B0); PG8_BAR; PG8_SCHED;
            PG8_STAGE(PG8_SB(1, 1), b3 + hstep, voffB);
            PG8_WAIT_V(6); PG8_BAR; PG8_MMA(1, 1, At, B1); PG8_BAR;
            }
        }
        if constexpr (ALIGN_EPI) { if (wr == 0) PG8_BAR; }
        if constexpr (!Epi::AFTER_DRAIN) { E(acc, cur, wr, wc, fr, fq); S.done(cur); }
        if (!has_next) break;
#pragma unroll
        for (int a = 0; a < 2; ++a)
#pragma unroll
            for (int b = 0; b < 2; ++b)
#pragma unroll
                for (int m = 0; m < 4; ++m)
#pragma unroll
                    for (int n = 0; n < 2; ++n) acc[a][b][m][n] = (f32x4){0.f, 0.f, 0.f, 0.f};
        cur = nxt; cA = nA; cB = nB; ++ui;
        if constexpr (ALIGN_EPI) { if (wr == 1) PG8_BAR; }
    }
    PG8_WAIT_V(0);
    if constexpr (!ALIGN_EPI) { if (wr == 0) PG8_BAR; }
    PG8_BAR;
    if constexpr (Epi::AFTER_DRAIN) { E.fused(acc, cur, wr, wc, fr, fq, lds, wid, lane); S.done(cur); }
#undef PG8_SA
#undef PG8_SB
#undef PG8_STAGE
#undef PG8_LDA
#undef PG8_LDB
#undef PG8_MMA
#undef PG8_WAIT_V
#undef PG8_WAIT_L
#undef PG8_BAR
#undef PG8_SCHED
}
}

#ifndef PH_MASK
#define PH_MASK 0xFFFFFFFFu
#endif
#define PHON(i) ((PH_MASK >> (i)) & 1u)
#ifndef REP_DSA
#define REP_DSA 1
#endif
#ifndef REP_DIFF
#define REP_DIFF 1
#endif
#ifndef REP_DIL
#define REP_DIL 1
#endif
#ifndef REP_SWI
#define REP_SWI 1
#endif
#ifndef REP_SYNC
#define REP_SYNC 0
#endif
#ifndef REP_PREP
#define REP_PREP 1
#endif
#ifndef DSA_REP_IDX
#define DSA_REP_IDX 1
#endif
#ifndef DSA_REP_TOPK
#define DSA_REP_TOPK 1
#endif
#ifndef DSA_REP_ATT
#define DSA_REP_ATT 1
#endif
#ifndef MK_ONE_LAUNCH
#define MK_ONE_LAUNCH 1
#endif
#define LAS __attribute__((address_space(3)))
typedef unsigned short bf16_t;
typedef short bf16x8 __attribute__((ext_vector_type(8)));
typedef short s16x4 __attribute__((ext_vector_type(4)));
typedef short v4i16_t __attribute__((ext_vector_type(4)));
typedef float f32x4 __attribute__((ext_vector_type(4)));
typedef float f32x16 __attribute__((ext_vector_type(16)));
typedef unsigned u32x4 __attribute__((ext_vector_type(4)));
typedef unsigned u32x2 __attribute__((ext_vector_type(2)));

constexpr int NB = 8, T = 2048, D = 1024, M = NB * T, FF = 2816, NGU = 2 * FF, PLE = 256;
constexpr int EVEN_N = 2816, ODD_N = 3072, EVEN_SRC = 2760;
constexpr int NWAVES = 8, NTHR = 512, LDS_BYTES = 147456;
constexpr size_t MiB = 1u << 20;
constexpr size_t WS_SSQ = 0;
constexpr size_t WS_BAR = 1216 * 1024, BAR_BYTES = 32768;
constexpr int LDS_MISC = LDS_BYTES - 256;
constexpr size_t WS_COS = 1280 * 1024, WS_SIN = WS_COS + 256 * 1024;
constexpr size_t WS_W = 2 * MiB;
constexpr size_t SZ_GU = (size_t)NGU * D * 2, SZ_WD = (size_t)D * FF * 2, SZ_FFN = 2 * (SZ_GU + SZ_WD);
constexpr size_t WS_FFN0 = WS_W, WS_FFN1 = WS_FFN0 + SZ_FFN;
constexpr size_t WS_PG = WS_FFN1 + SZ_FFN;
constexpr size_t WS_PP = WS_PG + 2 * (size_t)D * D * 2;
constexpr size_t WS_WIN_E = WS_PP + 2 * (size_t)D * PLE * 2;
constexpr size_t WS_WIN_O = WS_WIN_E + (size_t)EVEN_N * D * 2;
constexpr size_t WS_WOUT_E = WS_WIN_O + (size_t)ODD_N * D * 2;
constexpr size_t WS_WOUT_O = WS_WOUT_E + (size_t)D * D * 2;
constexpr size_t WS_WEND = WS_WOUT_O + (size_t)D * D * 2;
constexpr size_t WS_HBA = 89 * MiB;
constexpr size_t WS_HBB = 217 * MiB;
constexpr size_t WS_BIG = 121 * MiB;
constexpr size_t WS_MRG = 217 * MiB;
constexpr size_t WS_PBF = 249 * MiB;
constexpr size_t WS_END = 265 * MiB;
static_assert(WS_WEND <= WS_HBA && SZ_FFN >= (size_t)M * D * 2, "ws map");

using pg8::cvt_pk_bf16;
__device__ __forceinline__ float bf2f(bf16_t b) { return __uint_as_float(((unsigned)b) << 16); }
__device__ __forceinline__ int crow(int r, int hi) { return (r & 3) + 8 * (r >> 2) + 4 * hi; }
__device__ __forceinline__ s16x4 vtr(const LAS unsigned char* p) { return __builtin_bit_cast(s16x4, __builtin_amdgcn_ds_read_tr16_b64_v4i16((LAS v4i16_t*)p)); }
__device__ __forceinline__ float wave_sum(float v) {
#pragma unroll
    for (int o = 1; o < 64; o <<= 1) v += __shfl_xor(v, o);
    return v;
}
typedef float f32x2_t __attribute__((ext_vector_type(2))); typedef __bf16 bf16x2_t __attribute__((ext_vector_type(2)));
__device__ __forceinline__ unsigned cvtpk_c(float lo, float hi) { f32x2_t v = {lo, hi}; bf16x2_t b = __builtin_convertvector(v, bf16x2_t); return __builtin_bit_cast(unsigned, b); }
__device__ __forceinline__ bf16x8 pack8(float a0, float a1, float a2, float a3, float a4, float a5, float a6, float a7) {
    u32x4 w; w.x = cvtpk_c(a0, a1); w.y = cvtpk_c(a2, a3); w.z = cvtpk_c(a4, a5); w.w = cvtpk_c(a6, a7); return __builtin_bit_cast(bf16x8, w);
}
__device__ __forceinline__ f32x16 zero16() { f32x16 z = f32x16{}; asm volatile("" : "+v"(z)); return z; }
#define MFMA32(a, b, c) __builtin_amdgcn_mfma_f32_32x32x16_bf16((a), (b), (c), 0, 0, 0)
#define MFMA16(a, b, c) __builtin_amdgcn_mfma_f32_16x16x32_bf16((a), (b), (c), 0, 0, 0)

template <int NDT>
__device__ __forceinline__ void softmax_tile(f32x16& p, const f32x16& w, float& m, float& l, f32x16 (&o)[NDT], LAS float* wsf, int r32, int hi, bf16x8& pa0, bf16x8& pa1) {
    float tmax = -1e30f;
#pragma unroll
    for (int r = 0; r < 16; ++r) tmax = fmaxf(tmax, w[r] > 0.f ? p[r] : -1e30f);
    tmax = fmaxf(tmax, __shfl_xor(tmax, 32));
    const float mn = fmaxf(m, tmax), alpha = __builtin_amdgcn_exp2f(m - mn); m = mn;
    float rs = 0.f;
#pragma unroll
    for (int r = 0; r < 16; ++r) { p[r] = __builtin_amdgcn_exp2f(fminf(p[r] - mn, 0.f)) * w[r]; rs += p[r]; }
    l = l * alpha + rs;
    if (__any(alpha != 1.0f)) {
        if (hi == 0) wsf[r32] = alpha;
#pragma unroll
        for (int a = 0; a < 4; ++a) { const f32x4 al = *(const LAS f32x4*)(wsf + 8 * a + 4 * hi);
#pragma unroll
            for (int dt = 0; dt < NDT; ++dt) { o[dt][4 * a + 0] *= al[0]; o[dt][4 * a + 1] *= al[1]; o[dt][4 * a + 2] *= al[2]; o[dt][4 * a + 3] *= al[3]; } }
    }
    pa0 = pack8(p[0], p[1], p[2], p[3], p[4], p[5], p[6], p[7]);
    pa1 = pack8(p[8], p[9], p[10], p[11], p[12], p[13], p[14], p[15]);
}
template <int NDT>
__device__ __forceinline__ void softmax_tile_lw(f32x16& p, const f32x16& lw, float& m, float& l, f32x16 (&o)[NDT], LAS float* wsf, int r32, int hi, bf16x8& pa0, bf16x8& pa1) {
    float tmax = -1e30f;
#pragma unroll
    for (int r = 0; r < 16; ++r) { p[r] += lw[r]; tmax = fmaxf(tmax, p[r]); }
    tmax = fmaxf(tmax, __shfl_xor(tmax, 32));
    const float mn = fmaxf(m, tmax), alpha = __builtin_amdgcn_exp2f(m - mn); m = mn;
    float rs = 0.f;
#pragma unroll
    for (int r = 0; r < 16; ++r) { p[r] = __builtin_amdgcn_exp2f(p[r] - mn); rs += p[r]; }
    l = l * alpha + rs;
    if (__any(alpha != 1.0f)) {
        if (hi == 0) wsf[r32] = alpha;
#pragma unroll
        for (int a = 0; a < 4; ++a) { const f32x4 al = *(const LAS f32x4*)(wsf + 8 * a + 4 * hi);
#pragma unroll
            for (int dt = 0; dt < NDT; ++dt) { o[dt][4 * a + 0] *= al[0]; o[dt][4 * a + 1] *= al[1]; o[dt][4 * a + 2] *= al[2]; o[dt][4 * a + 3] *= al[3]; } }
    }
    pa0 = pack8(p[0], p[1], p[2], p[3], p[4], p[5], p[6], p[7]);
    pa1 = pack8(p[8], p[9], p[10], p[11], p[12], p[13], p[14], p[15]);
}
template <int NDT>
__device__ __forceinline__ void softmax_tile_sparse4(f32x16& p, const float (&A4)[4], float& m, float& l, f32x16 (&o)[NDT], LAS float* wsf, int r32, int hi, bf16x8& pa0, bf16x8& pa1) {
    float v[4];
#pragma unroll
    for (int a = 0; a < 4; ++a) v[a] = A4[0] > 0.f ? p[4 * a] : (A4[1] > 0.f ? p[4 * a + 1] : (A4[2] > 0.f ? p[4 * a + 2] : p[4 * a + 3]));
    float tmax = fmaxf(fmaxf(v[0], v[1]), fmaxf(v[2], v[3]));
    tmax = fmaxf(tmax, __shfl_xor(tmax, 32));
    const float mn = fmaxf(m, tmax), alpha = __builtin_amdgcn_exp2f(m - mn); m = mn;
    float rs = 0.f;
#pragma unroll
    for (int a = 0; a < 4; ++a) { v[a] = __builtin_amdgcn_exp2f(v[a] - mn); rs += v[a]; }
    l = l * alpha + rs;
    if (__any(alpha != 1.0f)) {
        if (hi == 0) wsf[r32] = alpha;
#pragma unroll
        for (int a = 0; a < 4; ++a) { const f32x4 al = *(const LAS f32x4*)(wsf + 8 * a + 4 * hi);
#pragma unroll
            for (int dt = 0; dt < NDT; ++dt) { o[dt][4 * a + 0] *= al[0]; o[dt][4 * a + 1] *= al[1]; o[dt][4 * a + 2] *= al[2]; o[dt][4 * a + 3] *= al[3]; } }
    }
#pragma unroll
    for (int r = 0; r < 16; ++r) p[r] = A4[r & 3] > 0.f ? v[r >> 2] : 0.f;
    pa0 = pack8(p[0], p[1], p[2], p[3], p[4], p[5], p[6], p[7]);
    pa1 = pack8(p[8], p[9], p[10], p[11], p[12], p[13], p[14], p[15]);
}
template <int NDT>
__device__ __forceinline__ void softmax_finish(float l, f32x16 (&o)[NDT], LAS float* wsf, int r32, int hi) {
    l += __shfl_xor(l, 32);
    if (hi == 0) wsf[r32] = 1.0f / l;
#pragma unroll
    for (int a = 0; a < 4; ++a) { const f32x4 al = *(const LAS f32x4*)(wsf + 8 * a + 4 * hi);
#pragma unroll
        for (int dt = 0; dt < NDT; ++dt) { o[dt][4 * a + 0] *= al[0]; o[dt][4 * a + 1] *= al[1]; o[dt][4 * a + 2] *= al[2]; o[dt][4 * a + 3] *= al[3]; } }
}

constexpr int EV_QA = 0, EV_QI = 512, EV_QB = 1024, EV_KB = 1536, EV_KA = 2048, EV_KI = 2112, EV_VA = 2176, EV_WI = 2240, EV_VB = 2304;
__device__ __forceinline__ void diff_unit(LAS unsigned char* lds, const bf16_t* proj, bf16_t* merged, const float* subln, float lam, int b, int hb, int qb, int tid, int wid, int lane) {
    const int r32 = lane & 31, hi = lane >> 5, comp = wid >> 2, qsub = wid & 3;
    const int qpos = qb * 128 + qsub * 32 + r32;
    const size_t rowb = (size_t)b * T;
    LAS float* wsf = (LAS float*)(lds + 65536 + wid * 256);
    bf16x8 qf[4];
    { const bf16_t* qp = proj + (rowb + qpos) * EVEN_N + EV_QB + 64 * (2 * hb + comp) + 8 * hi;
#pragma unroll
      for (int ks = 0; ks < 4; ++ks) qf[ks] = *(const bf16x8*)(qp + 16 * ks); }
    f32x16 o[4];
#pragma unroll
    for (int dt = 0; dt < 4; ++dt) o[dt] = f32x16{};
    float m = -1e30f, l = 0.f;
    const int nt = 4 * (qb + 1);
    const int kcomp = tid >> 8, kkey = (tid >> 3) & 31, kch = tid & 7, vkey = tid >> 4, vch = tid & 15;
    const bf16_t* kg = proj + (rowb + kkey) * EVEN_N + EV_KB + 64 * (2 * hb + kcomp) + 8 * kch;
    const bf16_t* vg = proj + (rowb + vkey) * EVEN_N + EV_VB + 128 * hb + 8 * vch;
    const int kdst = kcomp * 4096 + kkey * 128 + 16 * (kch ^ ((kkey >> 1) & 7));
    const int vdst = 8192 + vkey * 256 + 16 * (vch ^ ((vkey & 3) << 2));
    u32x4 kreg = *(const u32x4*)kg, vreg = *(const u32x4*)vg;
    const int qq = (lane & 15) >> 2, pp_ = lane & 3, g1 = (lane >> 4) & 1;
    for (int t = 0; t < nt; ++t) {
        const int buf = (t & 1) * 16384;
        *(LAS u32x4*)(lds + buf + kdst) = kreg; *(LAS u32x4*)(lds + buf + vdst) = vreg;
        __syncthreads();
        if (t + 1 < nt) { kreg = *(const u32x4*)(kg + (size_t)(t + 1) * 32 * EVEN_N); vreg = *(const u32x4*)(vg + (size_t)(t + 1) * 32 * EVEN_N); }
        if (32 * t <= qb * 128 + qsub * 32 + 31) {
            f32x16 p = zero16();
#pragma unroll
            for (int ks = 0; ks < 4; ++ks) { const bf16x8 kf = *(const LAS bf16x8*)(lds + buf + comp * 4096 + r32 * 128 + 16 * ((2 * ks + hi) ^ ((r32 >> 1) & 7))); p = MFMA32(kf, qf[ks], p); }
            f32x16 w;
#pragma unroll
            for (int r = 0; r < 16; ++r) w[r] = (32 * t + crow(r, hi) <= qpos) ? 1.f : 0.f;
            bf16x8 pa[2];
            softmax_tile<4>(p, w, m, l, o, wsf, r32, hi, pa[0], pa[1]);
#pragma unroll
            for (int s = 0; s < 2; ++s)
#pragma unroll
                for (int dt = 0; dt < 4; ++dt) { const int row = 16 * s + 4 * hi + qq, c = 4 * dt + 2 * g1 + (pp_ >> 1);
                    const s16x4 lo = vtr(lds + buf + 8192 + row * 256 + 16 * (c ^ (qq << 2)) + 8 * (pp_ & 1));
                    const s16x4 h4 = vtr(lds + buf + 8192 + (row + 8) * 256 + 16 * (c ^ (qq << 2)) + 8 * (pp_ & 1));
                    const bf16x8 bv = (bf16x8){lo[0], lo[1], lo[2], lo[3], h4[0], h4[1], h4[2], h4[3]};
                    o[dt] = MFMA32(pa[s], bv, o[dt]); }
        }
    }
    softmax_finish<4>(l, o, wsf, r32, hi);
    __syncthreads();
    LAS float* xb = (LAS float*)lds;
    if (comp == 1) {
#pragma unroll
        for (int dt = 0; dt < 4; ++dt)
#pragma unroll
            for (int r = 0; r < 16; ++r) xb[(qsub * 32 + crow(r, hi)) * 128 + 32 * dt + r32] = o[dt][r];
    }
    __syncthreads();
    if (comp == 0) {
        float g[4];
#pragma unroll
        for (int dt = 0; dt < 4; ++dt) g[dt] = subln[32 * dt + r32] * 0.8f;
#pragma unroll
        for (int r = 0; r < 16; ++r) { float ss = 0.f;
#pragma unroll
            for (int dt = 0; dt < 4; ++dt) { o[dt][r] -= lam * xb[(qsub * 32 + crow(r, hi)) * 128 + 32 * dt + r32]; ss += o[dt][r] * o[dt][r]; }
            ss += __shfl_xor(ss, 1); ss += __shfl_xor(ss, 2); ss += __shfl_xor(ss, 4); ss += __shfl_xor(ss, 8); ss += __shfl_xor(ss, 16);
            const float rs = rsqrtf(ss * (1.0f / 128.0f) + 1e-5f);
            bf16_t* op = merged + (rowb + qb * 128 + qsub * 32 + crow(r, hi)) * D + 512 + 128 * hb + r32;
#pragma unroll
            for (int dt = 0; dt < 4; ++dt) op[32 * dt] = (bf16_t)(cvtpk_c(o[dt][r] * rs * g[dt], 0.f) & 0xffffu); }
    }
    __syncthreads();
}

__device__ __forceinline__ int swz16(int k) { return ((k & 3) << 2) | ((k >> 2) & 3); }
__device__ __forceinline__ void dil_unit(LAS unsigned char* lds, const bf16_t* proj, bf16_t* merged, int b, int hp, int qb, int tid, int wid, int lane) {
    const int r32 = lane & 31, hi = lane >> 5, hsel = wid >> 2, cls = wid & 3, head = 2 * hp + hsel;
    const int P0 = 128 * qb, qpos = P0 + cls + 4 * r32;
    const size_t rowb = (size_t)b * T;
    LAS float* wsf = (LAS float*)(lds + 131072 + wid * 256);
    bf16x8 qf[4];
    { const bf16_t* qp = proj + (rowb + qpos) * ODD_N + 64 * head + 8 * hi;
#pragma unroll
      for (int ks = 0; ks < 4; ++ks) qf[ks] = *(const bf16x8*)(qp + 16 * ks); }
    f32x16 o[2]; o[0] = f32x16{}; o[1] = f32x16{};
    float m = -1e29f, l = 0.f;
    const int lpos = tid >> 4, lcc = tid & 15;
    const bf16_t* gsrc = proj + (rowb + lpos) * ODD_N + 1024 + 128 * hp + 8 * lcc;
    u32x4 pre[8];
#pragma unroll
    for (int i = 0; i < 8; ++i) pre[i] = *(const u32x4*)(gsrc + (size_t)(32 * (i & 3)) * ODD_N + (i >> 2) * 1024);
    const int qq = (lane & 15) >> 2, pp_ = lane & 3, g1 = (lane >> 4) & 1;
    for (int c = 0; c <= qb; ++c) {
        LAS unsigned char* lb = lds + (c & 1) * 65536;
#pragma unroll
        for (int i = 0; i < 8; ++i) { const int pos = lpos + 32 * (i & 3); *(LAS u32x4*)(lb + (i >> 2) * 32768 + pos * 256 + 16 * (lcc ^ swz16(pos >> 2))) = pre[i]; }
        __syncthreads();
        if (c < qb) {
#pragma unroll
            for (int i = 0; i < 8; ++i) pre[i] = *(const u32x4*)(gsrc + (size_t)(128 * (c + 1) + 32 * (i & 3)) * ODD_N + (i >> 2) * 1024);
        }
        const int dist = qb - c;
        for (int j = 0; j < 4; ++j) {
            if (j == cls || dist <= 1) {
                f32x16 p = zero16();
#pragma unroll
                for (int ks = 0; ks < 4; ++ks) { const bf16x8 kf = *(const LAS bf16x8*)(lb + (4 * r32 + j) * 256 + 16 * ((8 * hsel + 2 * ks + hi) ^ swz16(r32))); p = MFMA32(kf, qf[ks], p); }
                f32x16 w; const int d0 = qpos - (128 * c + j) - 16 * hi;
                float A4[4];
#pragma unroll
                for (int k = 0; k < 4; ++k) A4[k] = (((d0 - 4 * k) & 15) == 0) ? 1.f : 0.f;
                const float NEG = -1e30f, L3 = 1.5849625007211562f;
                if (j == cls) {
                    if (dist >= 5) {
#pragma unroll
                        for (int r = 0; r < 16; ++r) w[r] = A4[r & 3] > 0.f ? 0.f : NEG;
                    } else if (dist == 4) {
#pragma unroll
                        for (int r = 0; r < 16; ++r) { const bool c5 = (d0 - 4 * (r & 3) - 32 * (r >> 2)) <= 512; w[r] = A4[r & 3] > 0.f ? (c5 ? 1.f : 0.f) : (c5 ? 0.f : NEG); }
                    } else if (dist >= 2) {
#pragma unroll
                        for (int r = 0; r < 16; ++r) w[r] = A4[r & 3];
                    } else if (dist == 1) {
#pragma unroll
                        for (int r = 0; r < 16; ++r) { const bool c1 = (d0 - 4 * (r & 3) - 32 * (r >> 2)) <= 128; w[r] = A4[r & 3] > 0.f ? (c1 ? L3 : 1.f) : (c1 ? 1.f : 0.f); }
                    } else {
#pragma unroll
                        for (int r = 0; r < 16; ++r) { const bool g0 = (d0 - 4 * (r & 3) - 32 * (r >> 2)) >= 0; w[r] = g0 ? (A4[r & 3] > 0.f ? L3 : 1.f) : NEG; }
                    }
                } else if (dist == 1) {
#pragma unroll
                    for (int r = 0; r < 16; ++r) w[r] = ((d0 - 4 * (r & 3) - 32 * (r >> 2)) <= 128) ? 0.f : NEG;
                } else {
#pragma unroll
                    for (int r = 0; r < 16; ++r) w[r] = ((d0 - 4 * (r & 3) - 32 * (r >> 2)) >= 0) ? 0.f : NEG;
                }
                bf16x8 pa[2];
                if (j == cls && dist >= 5) softmax_tile_sparse4<2>(p, A4, m, l, o, wsf, r32, hi, pa[0], pa[1]);
                else softmax_tile_lw<2>(p, w, m, l, o, wsf, r32, hi, pa[0], pa[1]);
#pragma unroll
                for (int s = 0; s < 2; ++s)
#pragma unroll
                    for (int dt = 0; dt < 2; ++dt) { const int kap = 16 * s + 4 * hi + qq, cc = 8 * hsel + 4 * dt + 2 * g1 + (pp_ >> 1);
                        const s16x4 lo = vtr(lb + 32768 + (4 * kap + j) * 256 + 16 * (cc ^ swz16(kap)) + 8 * (pp_ & 1));
                        const s16x4 h4 = vtr(lb + 32768 + (4 * (kap + 8) + j) * 256 + 16 * (cc ^ swz16(kap + 8)) + 8 * (pp_ & 1));
                        const bf16x8 bv = (bf16x8){lo[0], lo[1], lo[2], lo[3], h4[0], h4[1], h4[2], h4[3]};
                        o[dt] = MFMA32(pa[s], bv, o[dt]); }
            }
        }
    }
    softmax_finish<2>(l, o, wsf, r32, hi);
#pragma unroll
    for (int r = 0; r < 16; ++r) { bf16_t* op = merged + (rowb + P0 + cls + 4 * crow(r, hi)) * D + 64 * head + r32;
        op[0] = (bf16_t)(cvtpk_c(o[0][r], 0.f) & 0xffffu); op[32] = (bf16_t)(cvtpk_c(o[1][r], 0.f) & 0xffffu); }
}

constexpr int DSA_WQ = 131072, DSA_SEL = 131584;
__device__ __forceinline__ unsigned mono_key(float f) { unsigned u = __float_as_uint(f); if (u == 0x80000000u) u = 0u; return (u & 0x80000000u) ? ~u : (u | 0x80000000u); }
__device__ __forceinline__ void dsa_unit(LAS unsigned char* lds, const bf16_t* proj, bf16_t* merged, int b, int qblk, int tid, int wid, int lane) {
    asm volatile("" : "+v"(lane), "+v"(tid));
    const int r32 = lane & 31, hi = lane >> 5, t0 = 16 * qblk;
    const size_t rowb = (size_t)b * T;
    LAS float* isc = (LAS float*)lds;
    LAS float* wq = (LAS float*)(lds + DSA_WQ);
    LAS unsigned short* sel = (LAS unsigned short*)(lds + DSA_SEL);
    if (tid < 128) wq[tid] = bf2f(proj[(rowb + t0 + (tid >> 3)) * EVEN_N + EV_WI + (tid & 7)]);
    for (int rep_i = 0; rep_i < DSA_REP_IDX; ++rep_i) {
    {
        bf16x8 af[4][4];
#pragma unroll
        for (int mt = 0; mt < 4; ++mt) { const int ql = 4 * mt + 2 * (r32 >> 4) + ((r32 >> 2) & 1), hd = 4 * ((r32 >> 3) & 1) + (r32 & 3);
            const bf16_t* ap = proj + (rowb + t0 + ql) * EVEN_N + EV_QI + 64 * hd + 8 * hi;
#pragma unroll
            for (int ks = 0; ks < 4; ++ks) af[mt][ks] = *(const bf16x8*)(ap + 16 * ks); }
        __syncthreads();
        const int nkt = (t0 + 16 + 31) >> 5;
        bf16x8 bnx[4];
        { const int kt0 = wid < nkt ? wid : 0; const bf16_t* bp = proj + (rowb + 32 * kt0 + r32) * EVEN_N + EV_KI + 8 * hi;
#pragma unroll
          for (int ks = 0; ks < 4; ++ks) bnx[ks] = *(const bf16x8*)(bp + 16 * ks); }
        for (int kt = wid; kt < nkt; kt += NWAVES) {
            bf16x8 bfr[4];
#pragma unroll
            for (int ks = 0; ks < 4; ++ks) bfr[ks] = bnx[ks];
            { const int ktn = (kt + NWAVES < nkt) ? kt + NWAVES : kt; const bf16_t* bp = proj + (rowb + 32 * ktn + r32) * EVEN_N + EV_KI + 8 * hi;
#pragma unroll
              for (int ks = 0; ks < 4; ++ks) bnx[ks] = *(const bf16x8*)(bp + 16 * ks); }
            const int key = 32 * kt + r32;
#pragma unroll
            for (int mt = 0; mt < 4; ++mt) { f32x16 acc = zero16();
#pragma unroll
                for (int ks = 0; ks < 4; ++ks) acc = MFMA32(af[mt][ks], bfr[ks], acc);
#pragma unroll
                for (int b4 = 0; b4 < 2; ++b4) { const int ql = 4 * mt + 2 * b4 + hi;
                    const f32x4 w0 = *(const LAS f32x4*)(wq + ql * 8), w1 = *(const LAS f32x4*)(wq + ql * 8 + 4);
                    float sc = w0[0] * fmaxf(acc[8 * b4 + 0], 0.f) + w0[1] * fmaxf(acc[8 * b4 + 1], 0.f) + w0[2] * fmaxf(acc[8 * b4 + 2], 0.f) + w0[3] * fmaxf(acc[8 * b4 + 3], 0.f)
                             + w1[0] * fmaxf(acc[8 * b4 + 4], 0.f) + w1[1] * fmaxf(acc[8 * b4 + 5], 0.f) + w1[2] * fmaxf(acc[8 * b4 + 6], 0.f) + w1[3] * fmaxf(acc[8 * b4 + 7], 0.f);
                    isc[ql * 2048 + key] = sc; } }
        }
    }
    __syncthreads();
    }
    for (int rep_t = 0; rep_t < DSA_REP_TOPK; ++rep_t) {
    int lane1 = lane; asm volatile("" : "+v"(lane1));
#pragma unroll
    for (int qi2 = 0; qi2 < 2; ++qi2) {
        const int ql = 2 * wid + qi2, t = t0 + ql, n = t + 1;
        if (n <= 256) {
#pragma unroll
            for (int j = 0; j < 4; ++j) sel[ql * 256 + lane1 + 64 * j] = (unsigned short)(lane1 + 64 * j);
        } else {
            unsigned kv[32];
#pragma unroll
            for (int j = 0; j < 32; ++j) { const int s = lane1 + 64 * j; kv[j] = (s < n) ? mono_key(isc[ql * 2048 + (s < 2048 ? s : 0)]) : 0u; }
            unsigned thr = 0u;
            const int ng = (n + 511) >> 9;
            for (int bit = 31; bit >= 0; --bit) { const unsigned cand = thr | (1u << bit); int cnt = 0;
#pragma unroll
                for (int g8 = 0; g8 < 4; ++g8) { if (g8 < ng) {
#pragma unroll
                    for (int j = 8 * g8; j < 8 * g8 + 8; ++j) cnt += __popcll(__ballot(kv[j] >= cand)); } }
                if (cnt >= 256) thr = cand;
                if (cnt == 256) break; }
            int cgt = 0;
#pragma unroll
            for (int j = 0; j < 32; ++j) cgt += __popcll(__ballot(kv[j] > thr));
            const int need = 256 - cgt;
            const unsigned long long ltmask = (1ull << lane1) - 1ull;
            int beq = 0, bsel = 0;
#pragma unroll
            for (int j = 0; j < 32; ++j) { const bool eq = kv[j] == thr; const unsigned long long em = __ballot(eq);
                const int rk = beq + __popcll(em & ltmask); beq += __popcll(em);
                const bool take = (kv[j] > thr) || (eq && rk < need);
                const unsigned long long sm = __ballot(take); const int pos = bsel + __popcll(sm & ltmask); bsel += __popcll(sm);
                if (take) sel[ql * 256 + pos] = (unsigned short)(lane1 + 64 * j); }
        }
    }
    }
    for (int rep_a = 0; rep_a < DSA_REP_ATT; ++rep_a) {
    LAS unsigned char* vst = lds + (2 * wid) * 8192;
#pragma unroll 1
    for (int qi2 = 0; qi2 < 2; ++qi2) {
        int lane2 = lane; asm volatile("" : "+v"(lane2));
        const int n15 = lane2 & 15, kg = lane2 >> 4, qq = n15 >> 2, pp_ = lane2 & 3;
        const int ql = 2 * wid + qi2, t = t0 + ql, nsel = (t + 1 < 256) ? t + 1 : 256;
        bf16x8 qb0, qb1;
        { const bf16_t* qp = proj + (rowb + t) * EVEN_N + EV_QA + 64 * (n15 & 7) + 8 * kg; qb0 = *(const bf16x8*)qp; qb1 = *(const bf16x8*)(qp + 32); }
        f32x4 S[16];
        u32x4 vv[16];
#pragma unroll
        for (int bt = 0; bt < 4; ++bt) {
            bf16x8 ka0[4], ka1[4];
#pragma unroll
            for (int t4 = 0; t4 < 4; ++t4) { const int pos = 16 * (4 * bt + t4) + n15; const int kidx = (pos < nsel) ? (int)sel[ql * 256 + pos] : 0;
                const bf16_t* kp = proj + (rowb + kidx) * EVEN_N + EV_KA + 8 * kg; ka0[t4] = *(const bf16x8*)kp; ka1[t4] = *(const bf16x8*)(kp + 32); }
#pragma unroll
            for (int t4 = 0; t4 < 4; ++t4) { const int tl = 4 * bt + t4;
                f32x4 acc = (f32x4){0.f, 0.f, 0.f, 0.f}; acc = MFMA16(ka0[t4], qb0, acc); acc = MFMA16(ka1[t4], qb1, acc);
#pragma unroll
                for (int i = 0; i < 4; ++i) S[tl][i] = (16 * tl + 4 * kg + i < nsel) ? acc[i] : -1e30f; }
            __builtin_amdgcn_sched_barrier(0);
        }
#pragma unroll
        for (int i = 0; i < 16; ++i) { const int e = lane2 + 64 * i, rho = e >> 3, ch = e & 7; const int kidx = (rho < nsel) ? (int)sel[ql * 256 + rho] : 0;
            vv[i] = *(const u32x4*)(proj + (rowb + kidx) * EVEN_N + EV_VA + 8 * ch); }
        float mx = -1e30f;
#pragma unroll
        for (int tl = 0; tl < 16; ++tl) mx = fmaxf(fmaxf(fmaxf(mx, S[tl][0]), fmaxf(S[tl][1], S[tl][2])), S[tl][3]);
        mx = fmaxf(mx, __shfl_xor(mx, 16)); mx = fmaxf(mx, __shfl_xor(mx, 32));
        float sum = 0.f;
#pragma unroll
        for (int tl = 0; tl < 16; ++tl)
#pragma unroll
            for (int i = 0; i < 4; ++i) { const float e = __builtin_amdgcn_exp2f(S[tl][i] - mx); S[tl][i] = e; sum += e; }
        sum += __shfl_xor(sum, 16); sum += __shfl_xor(sum, 32);
        const float inv = 1.0f / sum;
        f32x4 oacc[4];
#pragma unroll
        for (int dt = 0; dt < 4; ++dt) oacc[dt] = (f32x4){0.f, 0.f, 0.f, 0.f};
#pragma unroll
        for (int hh = 0; hh < 2; ++hh) {
#pragma unroll
            for (int i = 0; i < 16; ++i) { const int e = lane2 + 64 * i, rho = e >> 3, ch = e & 7;
                *(LAS u32x4*)(vst + rho * 128 + 16 * (ch ^ (((rho >> 1) & 3) << 1))) = vv[i]; }
            if (hh == 0) {
#pragma unroll
                for (int i = 0; i < 16; ++i) { const int e = lane2 + 64 * i, rho = e >> 3, ch = e & 7, pos = 128 + rho; const int kidx = (pos < nsel) ? (int)sel[ql * 256 + pos] : 0;
                    vv[i] = *(const u32x4*)(proj + (rowb + kidx) * EVEN_N + EV_VA + 8 * ch); }
            }
#pragma unroll
            for (int mm = 0; mm < 4; ++mm) { const int ms = 4 * hh + mm;
                const bf16x8 pa = pack8(S[2 * ms][0], S[2 * ms][1], S[2 * ms][2], S[2 * ms][3], S[2 * ms + 1][0], S[2 * ms + 1][1], S[2 * ms + 1][2], S[2 * ms + 1][3]);
#pragma unroll
                for (int dt = 0; dt < 4; ++dt) { const int rho = 32 * mm + 4 * kg + qq, ch = 2 * dt + (pp_ >> 1);
                    const s16x4 lo = vtr(vst + rho * 128 + 16 * (ch ^ (((rho >> 1) & 3) << 1)) + 8 * (pp_ & 1));
                    const s16x4 h4 = vtr(vst + (rho + 16) * 128 + 16 * (ch ^ ((((rho + 16) >> 1) & 3) << 1)) + 8 * (pp_ & 1));
                    const bf16x8 bv = (bf16x8){lo[0], lo[1], lo[2], lo[3], h4[0], h4[1], h4[2], h4[3]};
                    oacc[dt] = MFMA16(pa, bv, oacc[dt]); } }
        }
#pragma unroll
        for (int i = 0; i < 4; ++i) { const float il = __shfl(inv, (4 * kg + i) & 7);
            if (kg < 2) { bf16_t* op = merged + (rowb + t) * D + 64 * (4 * kg + i) + n15;
#pragma unroll
                for (int dt = 0; dt < 4; ++dt) op[16 * dt] = (bf16_t)(cvtpk_c(oacc[dt][i] * il, 0.f) & 0xffffu); } }
    }
    }
    __syncthreads();
}

enum { TK_PLAIN = 0, TK_SWIGLU = 1, TK_EVEN = 2, TK_ODD = 3 };
__device__ __forceinline__ int evencol(int G) {
    if (G < 8) return 64 * G; if (G < 16) return 640 + 64 * (G - 8); if (G < 24) return 1224 + 64 * (G - 16); if (G < 32) return 1736 + 64 * (G - 24);
    if (G == 32) return 512; if (G == 33) return 1152; if (G == 34) return 576; if (G == 35) return 1216; return 2248 + 64 * (G - 36);
}
__device__ __forceinline__ void transpose_item(const float* W0, const float* W1, const float* gain, int K, int Nsrc, int Ndst, bf16_t* WT, int kind, LAS float* scr, int item, int lane) {
    const int nblk = Ndst / 32, kb = item / nblk, nb = item % nblk, k0 = 64 * kb, n0 = 32 * nb;
    const float* src = W0; int col0 = n0, nvalid = 32;
    if (kind == TK_SWIGLU) { const int pn = n0 >> 8, bj = (n0 >> 7) & 1, y0 = n0 & 127; src = bj ? W1 : W0; col0 = 128 * pn + y0; }
    else if (kind == TK_EVEN) { const int pn = n0 >> 8, bj = (n0 >> 7) & 1, wc = (n0 >> 5) & 3, G = 4 * pn + wc; col0 = evencol(G) + 32 * bj; if (G == 35) nvalid = bj ? 0 : 8; }
    else if (kind == TK_ODD) { const int pn = n0 >> 8, bj = (n0 >> 7) & 1, wc = (n0 >> 5) & 3; col0 = 256 * pn + 64 * wc + 32 * bj; }
    const int ln = lane & 31;
    { float vv[32]; const float* sp = src + (size_t)(k0 + (lane >> 5)) * Nsrc + col0 + ln; const bool ok = ln < nvalid;
#pragma unroll
      for (int i = 0; i < 32; ++i) { vv[i] = ok ? *sp : 0.f; sp += 2 * Nsrc; asm volatile("" : "+v"(sp)); }
#pragma unroll
      for (int i = 0; i < 32; ++i) scr[(2 * i + (lane >> 5)) * 33 + ln] = vv[i]; }
    asm volatile("s_waitcnt lgkmcnt(0)" ::: "memory");
    const int c = lane & 7;
    f32x4 g0 = (f32x4){1.f, 1.f, 1.f, 1.f}, g1 = g0;
    if (gain) { g0 = *(const f32x4*)(gain + k0 + 8 * c); g1 = *(const f32x4*)(gain + k0 + 8 * c + 4); }
#pragma unroll
    for (int j = 0; j < 4; ++j) { const int n = (lane >> 3) + 8 * j; const LAS float* s = scr + (8 * c) * 33 + n;
        u32x4 o; o.x = cvt_pk_bf16(s[0 * 33] * g0[0], s[1 * 33] * g0[1]); o.y = cvt_pk_bf16(s[2 * 33] * g0[2], s[3 * 33] * g0[3]); o.z = cvt_pk_bf16(s[4 * 33] * g1[0], s[5 * 33] * g1[1]); o.w = cvt_pk_bf16(s[6 * 33] * g1[2], s[7 * 33] * g1[3]);
        *(u32x4*)(WT + (size_t)(n0 + n) * K + k0 + 8 * c) = o; }
    asm volatile("s_waitcnt lgkmcnt(0)" ::: "memory");
}

struct Args { const float* in[24]; float* out; unsigned char* ws; int ph_lo, ph_hi; };

__device__ __forceinline__ void prep_phase(const Args& a, LAS unsigned char* lds, int tid, int wid, int lane) {
    unsigned char* ws = a.ws;
    const int gw = blockIdx.x * NWAVES + wid, NGW = gridDim.x * NWAVES;
    const int gt = blockIdx.x * NTHR + tid, NGT = gridDim.x * NTHR;
    LAS float* scr = (LAS float*)(lds + wid * 16384);
    int base = 0;
    for (int job = 0; job < 16; ++job) {
        const float *W0 = nullptr, *W1 = nullptr, *gain = nullptr; bf16_t* dst = nullptr; int K = 1024, Nsrc = 1024, Ndst = 1024, kind = TK_PLAIN;
        if (job < 12) { const int l = job / 6, k = job % 6; const size_t fb = (l ? WS_FFN1 : WS_FFN0);
            if (k == 0) { W0 = a.in[3] + (size_t)l * D * FF; W1 = a.in[4] + (size_t)l * D * FF; gain = a.in[2] + l * D; dst = (bf16_t*)(ws + fb); Nsrc = FF; Ndst = NGU; kind = TK_SWIGLU; }
            else if (k == 1) { W0 = a.in[5] + (size_t)l * FF * D; dst = (bf16_t*)(ws + fb + SZ_GU); K = FF; }
            else if (k == 2) { W0 = a.in[8] + (size_t)l * D * FF; W1 = a.in[9] + (size_t)l * D * FF; gain = a.in[7] + l * D; dst = (bf16_t*)(ws + fb + SZ_GU + SZ_WD); Nsrc = FF; Ndst = NGU; kind = TK_SWIGLU; }
            else if (k == 3) { W0 = a.in[10] + (size_t)l * FF * D; dst = (bf16_t*)(ws + fb + 2 * SZ_GU + SZ_WD); K = FF; }
            else if (k == 4) { W0 = a.in[12] + (size_t)l * D * D; gain = a.in[11] + l * D; dst = (bf16_t*)(ws + WS_PG + (size_t)l * D * D * 2); }
            else { W0 = a.in[13] + (size_t)l * PLE * D; dst = (bf16_t*)(ws + WS_PP + (size_t)l * D * PLE * 2); K = PLE; }
        } else if (job == 12) { W0 = a.in[14]; gain = a.in[6]; dst = (bf16_t*)(ws + WS_WIN_E); Nsrc = EVEN_SRC; Ndst = EVEN_N; kind = TK_EVEN; }
        else if (job == 13) { W0 = a.in[15]; dst = (bf16_t*)(ws + WS_WOUT_E); }
        else if (job == 14) { W0 = a.in[21]; gain = a.in[6] + D; dst = (bf16_t*)(ws + WS_WIN_O); Nsrc = ODD_N; Ndst = ODD_N; kind = TK_ODD; }
        else { W0 = a.in[22]; dst = (bf16_t*)(ws + WS_WOUT_O); }
        const int nitems = (K / 64) * (Ndst / 32);
        for (int it = (gw + NGW - (base % NGW)) % NGW; it < nitems; it += NGW) transpose_item(W0, W1, gain, K, Nsrc, Ndst, dst, kind, scr, it, lane);
        base += nitems;
    }
    { const float* x = a.in[0]; pg8::ssq_t* ssq = (pg8::ssq_t*)(ws + WS_SSQ); bf16_t* hb = (bf16_t*)(ws + WS_HBA);
      for (int r = gw; r < M; r += 2 * NGW) { const int r2 = (r + NGW < M) ? r + NGW : r;
          const f32x4* xr = (const f32x4*)(x + (size_t)r * D) + lane; const f32x4* xr2 = (const f32x4*)(x + (size_t)r2 * D) + lane; f32x4 v[4], v2[4];
#pragma unroll
          for (int j = 0; j < 4; ++j) { v[j] = xr[64 * j]; v2[j] = xr2[64 * j]; }
          u32x2* br = (u32x2*)(hb + (size_t)r * D) + lane; u32x2* br2 = (u32x2*)(hb + (size_t)r2 * D) + lane; float s = 0.f, s2 = 0.f;
#pragma unroll
          for (int j = 0; j < 4; ++j) { u32x2 w; w.x = cvt_pk_bf16(v[j][0], v[j][1]); w.y = cvt_pk_bf16(v[j][2], v[j][3]); br[64 * j] = w; s += (v[j][0] * v[j][0] + v[j][1] * v[j][1]) + (v[j][2] * v[j][2] + v[j][3] * v[j][3]);
              w.x = cvt_pk_bf16(v2[j][0], v2[j][1]); w.y = cvt_pk_bf16(v2[j][2], v2[j][3]); br2[64 * j] = w; s2 += (v2[j][0] * v2[j][0] + v2[j][1] * v2[j][1]) + (v2[j][2] * v2[j][2] + v2[j][3] * v2[j][3]); }
          s = wave_sum(s); s2 = wave_sum(s2); if (lane == 0) { ssq[r] = (pg8::ssq_t)__float2ull_rn(s * pg8::SSQ_SCALE); ssq[r2] = (pg8::ssq_t)__float2ull_rn(s2 * pg8::SSQ_SCALE); } }
      for (int i = gt; i < 8 * M; i += NGT) ssq[M + i] = 0ull; }
    { const f32x4* p4 = (const f32x4*)a.in[1]; u32x2* o = (u32x2*)(ws + WS_PBF);
      for (int i = gt; i < 2 * M * PLE / 4; i += 4 * NGT) { f32x4 v[4];
#pragma unroll
          for (int j = 0; j < 4; ++j) v[j] = p4[i + j * NGT];
#pragma unroll
          for (int j = 0; j < 4; ++j) { u32x2 w; w.x = cvt_pk_bf16(v[j][0], v[j][1]); w.y = cvt_pk_bf16(v[j][2], v[j][3]); o[i + j * NGT] = w; } } }
    { float* cs = (float*)(ws + WS_COS); float* sn = (float*)(ws + WS_SIN);
      for (int i = gt; i < T * 32; i += NGT) { const int t = i >> 5, k = i & 31; const float inv = 1.0f / exp2f((float)k * (13.287712379549449f / 32.0f)); const float ang = (float)t * inv;
          float s, c; sincosf(ang, &s, &c); cs[i] = c; sn[i] = s; } }
}

#define XB_TMO      128
#define XB_XCNT(j)  (256  + 64 * (j))
#define XB_XSUB(j)  (1280 + 64 * (j))
#define XB_XGEN(j)  (2304 + 64 * (j))
#define XB_TOP      3328
#define XB_TOPGEN   3392
#define XCD_BAR_WORDS 3456
#define XB_SPIN_CAP (1u << 18)

__device__ __forceinline__ unsigned xb_ld(unsigned* p)              { return __hip_atomic_load(p, __ATOMIC_RELAXED, __HIP_MEMORY_SCOPE_AGENT); }
__device__ __forceinline__ unsigned xb_add(unsigned* p, unsigned v) { return __hip_atomic_fetch_add(p, v, __ATOMIC_RELAXED, __HIP_MEMORY_SCOPE_AGENT); }
__device__ __forceinline__ unsigned xb_xcc_id() { return (unsigned)__builtin_amdgcn_s_getreg((3 << 11) | 20) & 0xFu; }
#define XB_SPIN(cond, bar) do { unsigned _sp = 0; while (cond) { __builtin_amdgcn_s_sleep(1); \
    if ((++_sp & 255u) == 0u) { if (xb_ld(&(bar)[XB_TMO])) break; if (_sp > XB_SPIN_CAP) { atomicAdd(&(bar)[XB_TMO], 1u); break; } } } } while (0)

struct XcdBarrier {
    unsigned* bar; unsigned x;
    volatile LAS unsigned* st;
};

__device__ __forceinline__ XcdBarrier xcd_barrier_post(unsigned* bar, volatile LAS unsigned* st) {
    XcdBarrier b; b.bar = bar; b.x = xb_xcc_id(); b.st = st;
    if (threadIdx.x == 0) (void)xb_add(&bar[XB_XCNT(b.x)], 1u);
    return b;
}
__device__ __forceinline__ void xcd_barrier_complete(unsigned* bar, unsigned x, unsigned& nloc, unsigned& nx) {
    const unsigned G = gridDim.x * gridDim.y * gridDim.z;
    unsigned sum, cnt, mine, sp = 0u;
    for (;;) {
        sum = 0u; cnt = 0u; mine = 0u;
#pragma unroll
        for (unsigned j = 0; j < 16; ++j) { const unsigned c = xb_ld(&bar[XB_XCNT(j)]); sum += c; cnt += (c > 0u) ? 1u : 0u; mine = (j == x) ? c : mine; }
        if (sum == G) break;
        __builtin_amdgcn_s_sleep(1);
        if ((++sp & 255u) == 0u) { if (xb_ld(&bar[XB_TMO])) break; if (sp > XB_SPIN_CAP) { atomicAdd(&bar[XB_TMO], 1u); break; } }
    }
    nloc = mine > 0u ? mine : 1u; nx = cnt > 0u ? cnt : 1u;
}

__device__ __forceinline__ void xcd_barrier(const XcdBarrier& b) {
    asm volatile("s_waitcnt vmcnt(0)" ::: "memory");
    __syncthreads();
    if (threadIdx.x == 0) {
        unsigned* bar = b.bar;
        __builtin_amdgcn_s_waitcnt(0);
        unsigned nloc = b.st[0], nx = b.st[1];
        if (nloc == 0u) { xcd_barrier_complete(bar, b.x, nloc, nx); b.st[0] = nloc; b.st[1] = nx; }
        const unsigned old = xb_add(&bar[XB_XSUB(b.x)], 1u);
        const unsigned gen = old / nloc;
        if (old + 1u == (gen + 1u) * nloc) {
            __builtin_amdgcn_fence(__ATOMIC_RELEASE, "agent");
            asm volatile("s_waitcnt vmcnt(0)" ::: "memory");
            const unsigned og = xb_add(&bar[XB_TOP], 1u);
            const unsigned tg = og / nx;
            if (og + 1u == (tg + 1u) * nx) xb_add(&bar[XB_TOPGEN], 1u);
            else XB_SPIN(xb_ld(&bar[XB_TOPGEN]) == tg, bar);
            __builtin_amdgcn_fence(__ATOMIC_ACQUIRE, "agent");
            xb_add(&bar[XB_XGEN(b.x)], 1u);
            asm volatile("s_waitcnt vmcnt(0)" ::: "memory");
        } else {
            XB_SPIN(xb_ld(&bar[XB_XGEN(b.x)]) == gen, bar);
            __builtin_amdgcn_fence(__ATOMIC_ACQUIRE, "agent");
            asm volatile("s_waitcnt vmcnt(0)" ::: "memory");
        }
    }
    __syncthreads();
}

#define XL_SUB(j) (3584 + 64 * (j))
#define XL_GEN(j) (4608 + 64 * (j))
__device__ __forceinline__ void xcd_local_barrier(const XcdBarrier& b) {
    asm volatile("s_waitcnt vmcnt(0)" ::: "memory");
    __syncthreads();
    if (threadIdx.x == 0) {
        unsigned* bar = b.bar;
        __builtin_amdgcn_s_waitcnt(0);
        const unsigned nloc = b.st[0];
        const unsigned old = xb_add(&bar[XL_SUB(b.x)], 1u);
        const unsigned gen = old / nloc;
        if (old + 1u == (gen + 1u) * nloc) xb_add(&bar[XL_GEN(b.x)], 1u);
        else XB_SPIN(xb_ld(&bar[XL_GEN(b.x)]) == gen, bar);
        __builtin_amdgcn_fence(__ATOMIC_ACQUIRE, "agent");
        asm volatile("s_waitcnt vmcnt(0)" ::: "memory");
    }
    __syncthreads();
}

struct PpOrder { pg8::StaticOrder so; int xcc, rank; bool local;
    __device__ __forceinline__ bool next(int i, pg8::Unit& u) const { if (!local) return so.next(i, u); if (rank < 16 || i >= 2) return false; const int j = (rank - 16) * 2 + i; u.pm = 8 * xcc + (j & 7); u.pn = j >> 3; return true; }
    __device__ __forceinline__ void a_ready(const pg8::Unit&) const {}
    __device__ __forceinline__ void done(const pg8::Unit&) const {}
};
#define IN(k) (lo <= (k) && (k) < hi)
#define TIDS int tid = threadIdx.x; asm volatile("" : "+v"(tid)); const int lane = tid & 63, wid = __builtin_amdgcn_readfirstlane(tid >> 6)
#define SEAM(k) do { if (IN(k) && IN((k) + 1)) { if (local_ok) xcd_local_barrier(xbar); else xcd_barrier(xbar); } } while (0)
#define PTRS unsigned char* ws = a.ws; asm volatile("" : "+s"(ws)); pg8::ssq_t* ssq = (pg8::ssq_t*)(ws + WS_SSQ); float* h = a.out; \
    bf16_t* hbA = (bf16_t*)(ws + WS_HBA); bf16_t* hbB = (bf16_t*)(ws + WS_HBB); bf16_t* big = (bf16_t*)(ws + WS_BIG); bf16_t* mrg = (bf16_t*)(ws + WS_MRG); \
    (void)ssq; (void)h; (void)hbA; (void)hbB; (void)big; (void)mrg
#define GEMM_SWIGLU(L, SECOND) do { PTRS; \
    pg8::Gemm g{(SECOND) ? hbA : ((L) == 0 ? hbA : hbB), (const bf16_t*)(ws + ((L) ? WS_FFN1 : WS_FFN0) + ((SECOND) ? SZ_GU + SZ_WD : 0)), M, NGU, D}; pg8::StaticOrder S; S.init(M, NGU, G, c); \
    pg8::EpiSwiglu E{big, ssq + (size_t)(4 * (L) + ((SECOND) ? 2 : 0)) * M}; \
    pg8::gemm_phase<pg8::EpiSwiglu, pg8::StaticOrder, true, true>(lds, g, S, E); } while (0)
#define GEMM_RESID(A_, BT_, K_, SSQI, SC, HIN) do { PTRS; \
    pg8::Gemm g{(A_), (const bf16_t*)(ws + (BT_)), M, D, (K_)}; pg8::StaticOrder S; S.init(M, D, G, c); \
    pg8::EpiResid E{(HIN), h, hbA, ssq + (size_t)(SSQI) * M, (SC)}; \
    pg8::gemm_phase<pg8::EpiResid, pg8::StaticOrder, true, true>(lds, g, S, E); } while (0)
#define LAYER(L) do { const int k0 = 1 + 8 * (L); \
    if (IN(k0 + 0) && PHON(1)) for (int rep = 0; rep < REP_SWI; ++rep) GEMM_SWIGLU(L, 0); \
    SEAM(k0 + 0); \
    if (IN(k0 + 1) && PHON(2)) GEMM_RESID(big, ((L) ? WS_FFN1 : WS_FFN0) + SZ_GU, FF, 4 * (L) + 1, 0.5f, ((L) == 0 ? a.in[0] : (const float*)h)); \
    SEAM(k0 + 1); \
    if (IN(k0 + 2) && PHON(3)) { PTRS; constexpr int N = ((L) == 0) ? EVEN_N : ODD_N; \
        pg8::Gemm g{hbA, (const bf16_t*)(ws + ((L) == 0 ? WS_WIN_E : WS_WIN_O)), M, N, D}; pg8::StaticOrder S; S.init(M, N, G, c); \
        pg8::EpiProj E{big, N, ssq + (size_t)(4 * (L) + 1) * M, (const float*)(ws + WS_COS), (const float*)(ws + WS_SIN), ((L) == 0) ? 0x3FFFFFFFFull : 0xFFFFFFFFull, ((L) == 0) ? 0x00FF00FFull : 0xFFFFull}; \
        pg8::gemm_phase<pg8::EpiProj, pg8::StaticOrder, true, true>(lds, g, S, E); } \
    SEAM(k0 + 2); \
    if (IN(k0 + 3)) { PTRS; \
        if ((L) == 0) { \
            if (PHON(4)) for (int rep = 0; rep < REP_DSA; ++rep) { TIDS; for (int j = 0; j < 4; ++j) { const int rk = c >> 3; dsa_unit(lds, big, mrg, c & 7, (j == 0) ? rk : (j == 1) ? 63 - rk : (j == 2) ? 64 + rk : 127 - rk, tid, wid, lane); } } \
            if (PHON(5)) { TIDS; float lam; { const float s1 = wave_sum(a.in[16][lane] * a.in[17][lane]), s2 = wave_sum(a.in[18][lane] * a.in[19][lane]); lam = expf(s1) - expf(s2) + 0.2f; } \
                for (int rep = 0; rep < REP_DIFF; ++rep) { const int b = c & 7, hb = (c >> 6) & 3, s = (c >> 3) & 7; \
                    diff_unit(lds, big, mrg, a.in[20], lam, b, hb, 15 - s, tid, wid, lane); \
                    diff_unit(lds, big, mrg, a.in[20], lam, b, hb, s, tid, wid, lane); } } \
        } else { \
            if (PHON(6)) for (int rep = 0; rep < REP_DIL; ++rep) { TIDS; for (int j = 0; j < 2; ++j) { const int b = c & 7, hp = ((c >> 6) & 3) + 4 * j, s = (c >> 3) & 7; \
                dil_unit(lds, big, mrg, b, hp, 15 - s, tid, wid, lane); __syncthreads(); \
                dil_unit(lds, big, mrg, b, hp, s, tid, wid, lane); __syncthreads(); } } \
        } } \
    SEAM(k0 + 3); \
    if (IN(k0 + 4) && PHON(2)) GEMM_RESID(mrg, ((L) == 0 ? WS_WOUT_E : WS_WOUT_O), D, 4 * (L) + 2, 1.0f, (const float*)h); \
    SEAM(k0 + 4); \
    if (IN(k0 + 5)) { if (PHON(1)) GEMM_SWIGLU(L, 1); \
        if (PHON(8)) { PTRS; pg8::Gemm g2{(const bf16_t*)(ws + WS_PBF) + (size_t)(L) * M * PLE, (const bf16_t*)(ws + WS_PP) + (size_t)(L) * D * PLE, M, D, PLE}; pg8::StaticOrder S2; S2.init(M, D, G, c); \
            pg8::EpiPlain E2{mrg, D}; PpOrder S3{S2, c & 7, c >> 3, local_ok}; pg8::gemm_phase<pg8::EpiPlain, PpOrder, true, true>(lds, g2, S3, E2); } } \
    SEAM(k0 + 5); \
    if (IN(k0 + 6) && PHON(2)) GEMM_RESID(big, ((L) ? WS_FFN1 : WS_FFN0) + 2 * SZ_GU + SZ_WD, FF, 4 * (L) + 3, 0.5f, (const float*)h); \
    SEAM(k0 + 6); \
    if (IN(k0 + 7) && PHON(7)) { PTRS; pg8::Gemm g{hbA, (const bf16_t*)(ws + WS_PG) + (size_t)(L) * D * D, M, D, D}; pg8::StaticOrder S; S.init(M, D, G, c); \
        pg8::EpiPle E{h, hbB, mrg, ssq + (size_t)(4 * (L) + 3) * M, ssq + (size_t)(4 * (L) + 4) * M}; \
        pg8::gemm_phase<pg8::EpiPle, pg8::StaticOrder, true, true>(lds, g, S, E); } \
    SEAM(k0 + 7); } while (0)

__global__ void __launch_bounds__(NTHR, 2) mega_fwd(Args a) {
    extern __shared__ __attribute__((aligned(16))) unsigned char lds_raw[];
    LAS unsigned char* lds = (LAS unsigned char*)lds_raw;
    cg::grid_group grid = cg::this_grid();
    const int G = gridDim.x;
    const int lo = a.ph_lo, hi = a.ph_hi;
    volatile LAS unsigned* MISC = (volatile LAS unsigned*)(lds + LDS_MISC);
    if (threadIdx.x < 64) MISC[threadIdx.x] = 0u;
    __syncthreads();
    XcdBarrier xbar; xbar.bar = (unsigned*)(a.ws + WS_BAR); xbar.x = xb_xcc_id(); xbar.st = MISC;
    if (threadIdx.x == 0) MISC[3] = xb_add(&xbar.bar[XB_XCNT(xbar.x)], 1u);
    for (int rep = 0; rep < REP_SYNC; ++rep) grid.sync();
    if (IN(0) && PHON(0)) for (int rep = 0; rep < REP_PREP; ++rep) { TIDS; prep_phase(a, lds, tid, wid, lane); }
    int c = blockIdx.x; bool local_ok = false;
    if (IN(0) && IN(1)) {
        if (lo != 0) grid.sync();
        else {
            asm volatile("s_waitcnt vmcnt(0)" ::: "memory"); __syncthreads();
            if (threadIdx.x == 0) { __builtin_amdgcn_fence(__ATOMIC_RELEASE, "agent"); asm volatile("s_waitcnt vmcnt(0)" ::: "memory"); }
            xcd_barrier(xbar);
        }
        if (threadIdx.x == 0) { unsigned okc = (G == 256) ? 1u : 0u, nx = 0u;
            for (unsigned j = 0; j < 16; ++j) { const unsigned cn = xb_ld(&xbar.bar[XB_XCNT(j)]); nx += cn > 0u ? 1u : 0u; if (cn != (j < 8u ? (unsigned)G / 8u : 0u)) okc = 0u; }
            const unsigned mine = xb_ld(&xbar.bar[XB_XCNT(xbar.x)]);
            MISC[0] = mine > 0u ? mine : 1u; MISC[1] = nx > 0u ? nx : 1u; MISC[4] = okc; }
        __syncthreads();
        local_ok = __builtin_amdgcn_readfirstlane(MISC[4]) != 0u;
        if (local_ok) c = (int)__builtin_amdgcn_readfirstlane(xbar.x + 8u * MISC[3]);
    }
    LAYER(0);
    LAYER(1);
    if (IN(17) && PHON(9)) { TIDS; PTRS;
        const float* fg = a.in[23]; const pg8::ssq_t* sq = ssq + 8 * M;
        for (int r = (c & 7) * T + (c >> 3) * NWAVES + wid; r < ((c & 7) + 1) * T; r += (G >> 3) * NWAVES) { const float ri = pg8::rinv_of(sq, r); f32x4* hr = (f32x4*)(h + (size_t)r * D) + lane; const f32x4* g4 = (const f32x4*)fg + lane;
#pragma unroll
            for (int j = 0; j < 4; ++j) hr[64 * j] = hr[64 * j] * ri * g4[64 * j]; }
    }
}

extern "C" void kernel_launch(void* const* d_in, const int* in_sizes, int n_in, void* d_out, int out_size, void* d_ws, size_t ws_size, hipStream_t stream) {
    static int grid = 0;
    if (grid == 0) {
        if (n_in != 24 || out_size != M * D || ws_size < WS_END) { fprintf(stderr, "kernel_launch: unexpected shapes: n_in %d out %d ws %zu (need %zu)\n", n_in, out_size, ws_size, (size_t)WS_END); grid = -1; return; }
        int dev = 0, cus = 0, per_cu = 0;
        hipGetDevice(&dev); hipDeviceGetAttribute(&cus, hipDeviceAttributeMultiprocessorCount, dev);
        if (hipFuncSetAttribute((const void*)mega_fwd, hipFuncAttributeMaxDynamicSharedMemorySize, LDS_BYTES) != hipSuccess) { fprintf(stderr, "kernel_launch: hipFuncSetAttribute failed\n"); grid = -1; return; }
        if (hipOccupancyMaxActiveBlocksPerMultiprocessor(&per_cu, (const void*)mega_fwd, NTHR, LDS_BYTES) != hipSuccess || per_cu < 1) { fprintf(stderr, "kernel_launch: occupancy query says %d blocks/CU\n", per_cu); per_cu = 1; }
        (void)hipGetLastError();
        grid = cus * 1;
        fprintf(stderr, "kernel_launch: grid %d (cus %d, per_cu %d)\n", grid, cus, per_cu);
    }
    if (grid < 0) return;
    if (hipMemsetAsync((char*)d_ws + WS_BAR, 0, BAR_BYTES, stream) != hipSuccess) { fprintf(stderr, "kernel_launch: memset failed\n"); return; }
    Args a{};
    for (int i = 0; i < 24; ++i) a.in[i] = (const float*)d_in[i];
    a.out = (float*)d_out; a.ws = (unsigned char*)d_ws;
#if MK_ONE_LAUNCH
    a.ph_lo = 0; a.ph_hi = 18;
    { void* args[] = {&a}; hipError_t e = hipLaunchCooperativeKernel((const void*)mega_fwd, dim3(grid), dim3(NTHR), args, LDS_BYTES, stream);
      if (e != hipSuccess) fprintf(stderr, "cooperative launch failed: %s\n", hipGetErrorString(e)); }
#else
    for (int ph = 0; ph < 18; ++ph) { a.ph_lo = ph; a.ph_hi = ph + 1; void* args[] = {&a};
        hipError_t e = hipLaunchCooperativeKernel((const void*)mega_fwd, dim3(grid), dim3(NTHR), args, LDS_BYTES, stream);
        if (e != hipSuccess) { fprintf(stderr, "launch %d failed: %s\n", ph, hipGetErrorString(e)); break; } }
#endif
}
```

```cpp
#include <hip/hip_runtime.h>
#include <hip/hip_cooperative_groups.h>
#include <cstdio>
#include <cstdint>
namespace cg = cooperative_groups;
namespace pg8 {
#define PG8_LAS __attribute__((address_space(3)))
typedef unsigned short bf16_t;
typedef short bf16x8 __attribute__((ext_vector_type(8)));
typedef float f32x4 __attribute__((ext_vector_type(4)));
typedef unsigned u32x4 __attribute__((ext_vector_type(4)));
constexpr int BM = 256, BK = 64, HALF = 128, HTB = HALF * BK * 2  , STAGE_BYTES = 8 * HTB, NXCD = 8, WGM = 8;

__host__ __device__ __forceinline__ int lds_byte(int r, int c) { const int st = (r >> 4) * 2 + (c >> 5), rr = r & 15, cc = c & 31, ob = rr * 64 + cc * 2; return st * 1024 + (ob ^ (((ob >> 9) & 1) << 5)); }
__host__ __device__ __forceinline__ void stage_rc(int b, int& R, int& C) { const int st = b / 1024, sb = b % 1024, swz = sb ^ (((sb >> 9) & 1) << 5); R = (st >> 1) * 16 + swz / 64; C = (st & 1) * 32 + (swz % 64) / 2; }
__host__ __device__ __forceinline__ int perm32(int rho) { const int n = rho >> 4, i = rho & 15; return 8 * (i >> 2) + 4 * n + (i & 3); }

struct Unit { int pm, pn; };
struct Gemm { const bf16_t* A; const bf16_t* Bt; int M, N, K; };

struct StaticOrder {
    int nM, nN, nwg, G, c;
    __host__ __device__ void init(int M, int N, int G_, int c_) { nM = M / BM; nN = N / BM; nwg = nM * nN; G = G_; c = c_; }
    __host__ __device__ bool next(int i, Unit& u) const {
        const long L = (long)i * G + c; if (L >= nwg) return false;
        int wgid = (int)L; { const int q = nwg / NXCD, r = nwg % NXCD, xcd = wgid % NXCD, off = wgid / NXCD; wgid = (xcd < r ? xcd * (q + 1) : r * (q + 1) + (xcd - r) * q) + off; }
        const int nig = WGM * nN, gid = wgid / nig, fm = gid * WGM, gsz = (nM - fm) < WGM ? (nM - fm) : WGM;
        u.pm = fm + ((wgid % nig) % gsz); u.pn = (wgid % nig) / gsz; return true;
    }
    __device__ __forceinline__ void a_ready(const Unit&) const {}
    __device__ __forceinline__ void done(const Unit&) const {}
};

__device__ __forceinline__ unsigned cvt_pk_bf16(float lo, float hi) { unsigned r; asm volatile("v_cvt_pk_bf16_f32 %0, %1, %2" : "=v"(r) : "v"(lo), "v"(hi)); return r; }
typedef unsigned u32x2 __attribute__((ext_vector_type(2)));
constexpr float RMS_EPS = 1e-6f, LOG2E = 1.4426950408889634f, C2S = 0.125f * 1.4426950408889634f;
typedef unsigned long long ssq_t;
constexpr float SSQ_SCALE = 1048576.0f, SSQ_INV = 1.0f / (1048576.0f * 1024.0f);
__device__ __forceinline__ float rinv_of(const ssq_t* ssq, int row) { return rsqrtf((float)ssq[row] * SSQ_INV + RMS_EPS); }
__device__ __forceinline__ void ssq_add(ssq_t* p, float v) { atomicAdd(p, (ssq_t)__float2ull_rn(v * SSQ_SCALE)); }
__device__ __forceinline__ float bf2f(unsigned short b) { return __uint_as_float(((unsigned)b) << 16); }

struct EpiSwiglu { static constexpr bool PERM = true, AFTER_DRAIN = false;
    bf16_t* O; const ssq_t* ssq;
    __device__ __forceinline__ void operator()(const f32x4 (&acc)[2][2][4][2], const Unit& u, int wr, int wc, int fr, int fq) const {
        const int row0 = u.pm * BM + wr * 64 + fr, col0 = u.pn * 128 + wc * 32 + 8 * fq;
#pragma unroll
        for (int ai = 0; ai < 2; ++ai)
#pragma unroll
            for (int m = 0; m < 4; ++m) { const int row = row0 + ai * HALF + m * 16; const float ri = rinv_of(ssq, row); float o[8];
#pragma unroll
                for (int n = 0; n < 2; ++n)
#pragma unroll
                    for (int j = 0; j < 4; ++j) { const float g = acc[ai][0][m][n][j] * ri, up = acc[ai][1][m][n][j] * ri;
                        o[n * 4 + j] = g * up * __builtin_amdgcn_rcpf(1.0f + __builtin_amdgcn_exp2f(-LOG2E * g)); }
                u32x4 w; w.x = cvt_pk_bf16(o[0], o[1]); w.y = cvt_pk_bf16(o[2], o[3]); w.z = cvt_pk_bf16(o[4], o[5]); w.w = cvt_pk_bf16(o[6], o[7]);
                *(u32x4*)(O + (size_t)row * 2816 + col0) = w; }
    }
};
struct EpiResid { static constexpr bool PERM = false, AFTER_DRAIN = false;
    const float* hin; float* h; bf16_t* hb; ssq_t* ssq_out; float sc;
    __device__ __forceinline__ void operator()(const f32x4 (&acc)[2][2][4][2], const Unit& u, int wr, int wc, int fr, int fq) const {
        const int row0 = u.pm * BM + wr * 64 + fr, col0 = u.pn * BM + wc * 32 + 4 * fq;
#pragma unroll
        for (int ai = 0; ai < 2; ++ai)
#pragma unroll
            for (int m = 0; m < 4; ++m) { const int row = row0 + ai * HALF + m * 16; float ss = 0.f;
#pragma unroll
                for (int bj = 0; bj < 2; ++bj)
#pragma unroll
                    for (int n = 0; n < 2; ++n) { const size_t off = (size_t)row * 1024 + col0 + bj * HALF + n * 16;
                        f32x4 o = *(const f32x4*)(hin + off) + acc[ai][bj][m][n] * sc; *(f32x4*)(h + off) = o;
                        u32x2 w; w.x = cvt_pk_bf16(o[0], o[1]); w.y = cvt_pk_bf16(o[2], o[3]); *(u32x2*)(hb + off) = w;
                        ss += (o[0] * o[0] + o[1] * o[1]) + (o[2] * o[2] + o[3] * o[3]); }
                ss += __shfl_xor(ss, 16); ss += __shfl_xor(ss, 32);
                if (fq == 0) ssq_add(ssq_out + row, ss);
                asm volatile("" ::: "memory"); }
    }
};
struct EpiPle { static constexpr bool PERM = false, AFTER_DRAIN = false;
    float* h; bf16_t* hb; const bf16_t* pp; const ssq_t* ssq_in; ssq_t* ssq_out;
    __device__ __forceinline__ void operator()(const f32x4 (&acc)[2][2][4][2], const Unit& u, int wr, int wc, int fr, int fq) const {
        const int row0 = u.pm * BM + wr * 64 + fr, col0 = u.pn * BM + wc * 32 + 4 * fq;
#pragma unroll
        for (int ai = 0; ai < 2; ++ai)
#pragma unroll
            for (int m = 0; m < 4; ++m) { const int row = row0 + ai * HALF + m * 16; const float ri = rinv_of(ssq_in, row); float ss = 0.f;
#pragma unroll
                for (int bj = 0; bj < 2; ++bj)
#pragma unroll
                    for (int n = 0; n < 2; ++n) { const size_t off = (size_t)row * 1024 + col0 + bj * HALF + n * 16;
                        const f32x4 hv = *(const f32x4*)(h + off); const u32x2 pv = *(const u32x2*)(pp + off); f32x4 o;
                        const float p0 = __uint_as_float(pv.x << 16), p1 = __uint_as_float(pv.x & 0xffff0000u), p2 = __uint_as_float(pv.y << 16), p3 = __uint_as_float(pv.y & 0xffff0000u);
                        const f32x4 g = acc[ai][bj][m][n] * ri;
                        o[0] = hv[0] + p0 * __builtin_amdgcn_rcpf(1.0f + __builtin_amdgcn_exp2f(-LOG2E * g[0]));
                        o[1] = hv[1] + p1 * __builtin_amdgcn_rcpf(1.0f + __builtin_amdgcn_exp2f(-LOG2E * g[1]));
                        o[2] = hv[2] + p2 * __builtin_amdgcn_rcpf(1.0f + __builtin_amdgcn_exp2f(-LOG2E * g[2]));
                        o[3] = hv[3] + p3 * __builtin_amdgcn_rcpf(1.0f + __builtin_amdgcn_exp2f(-LOG2E * g[3]));
                        *(f32x4*)(h + off) = o;
                        u32x2 w; w.x = cvt_pk_bf16(o[0], o[1]); w.y = cvt_pk_bf16(o[2], o[3]); *(u32x2*)(hb + off) = w;
                        ss += (o[0] * o[0] + o[1] * o[1]) + (o[2] * o[2] + o[3] * o[3]); }
                ss += __shfl_xor(ss, 16); ss += __shfl_xor(ss, 32);
                if (fq == 0) ssq_add(ssq_out + row, ss);
                asm volatile("" ::: "memory"); }
    }
};
struct EpiPlain { static constexpr bool PERM = true, AFTER_DRAIN = false;
    bf16_t* O; int ldo;
    __device__ __forceinline__ void operator()(const f32x4 (&acc)[2][2][4][2], const Unit& u, int wr, int wc, int fr, int fq) const {
        const int row0 = u.pm * BM + wr * 64 + fr, col0 = u.pn * BM + wc * 32 + 8 * fq;
#pragma unroll
        for (int ai = 0; ai < 2; ++ai)
#pragma unroll
            for (int m = 0; m < 4; ++m) { bf16_t* rowp = O + (size_t)(row0 + ai * HALF + m * 16) * ldo + col0;
#pragma unroll
                for (int bj = 0; bj < 2; ++bj) { const f32x4 v0 = acc[ai][bj][m][0], v1 = acc[ai][bj][m][1];
                    u32x4 w; w.x = cvt_pk_bf16(v0[0], v0[1]); w.y = cvt_pk_bf16(v0[2], v0[3]); w.z = cvt_pk_bf16(v1[0], v1[1]); w.w = cvt_pk_bf16(v1[2], v1[3]);
                    *(u32x4*)(rowp + bj * HALF) = w; } }
    }
};
struct EpiProj { static constexpr bool PERM = true, AFTER_DRAIN = false;
    bf16_t* O; int ldo; const ssq_t* ssq; const float* cs; const float* sn; unsigned long long ropemask, sclmask;
    __device__ __forceinline__ void operator()(const f32x4 (&acc)[2][2][4][2], const Unit& u, int wr, int wc, int fr, int fq) const {
        const int G = 4 * u.pn + wc; const bool rope = (ropemask >> G) & 1ull; const float scl = ((sclmask >> G) & 1ull) ? C2S : 1.0f;
        const int row0 = u.pm * BM + wr * 64 + fr, ocol = u.pn * BM + wc * 64 + 8 * fq;
#pragma unroll
        for (int ai = 0; ai < 2; ++ai)
#pragma unroll
            for (int m = 0; m < 4; ++m) { const int row = row0 + ai * HALF + m * 16; const float ri = rinv_of(ssq, row) * scl; const int pos = row & 2047;
                f32x4 a0 = acc[ai][0][m][0] * ri, a1 = acc[ai][0][m][1] * ri, b0 = acc[ai][1][m][0] * ri, b1 = acc[ai][1][m][1] * ri;
                if (rope) { const f32x4 c0 = *(const f32x4*)(cs + pos * 32 + 8 * fq), c1 = *(const f32x4*)(cs + pos * 32 + 8 * fq + 4);
                    const f32x4 s0 = *(const f32x4*)(sn + pos * 32 + 8 * fq), s1 = *(const f32x4*)(sn + pos * 32 + 8 * fq + 4);
                    const f32x4 na0 = a0 * c0 - b0 * s0, na1 = a1 * c1 - b1 * s1, nb0 = b0 * c0 + a0 * s0, nb1 = b1 * c1 + a1 * s1; a0 = na0; a1 = na1; b0 = nb0; b1 = nb1; }
                u32x4 w; w.x = cvt_pk_bf16(a0[0], a0[1]); w.y = cvt_pk_bf16(a0[2], a0[3]); w.z = cvt_pk_bf16(a1[0], a1[1]); w.w = cvt_pk_bf16(a1[2], a1[3]);
                *(u32x4*)(O + (size_t)row * ldo + ocol) = w;
                w.x = cvt_pk_bf16(b0[0], b0[1]); w.y = cvt_pk_bf16(b0[2], b0[3]); w.z = cvt_pk_bf16(b1[0], b1[1]); w.w = cvt_pk_bf16(b1[2], b1[3]);
                *(u32x4*)(O + (size_t)row * ldo + ocol + 32) = w; }
    }
};
template <class Epi, class Sched, bool ALIGN_EPI = false, bool SP2 = false>
__device__ __forceinline__ void gemm_phase(PG8_LAS unsigned char* lds, const Gemm g, const Sched& S, const Epi& E) {
    int tid_ = threadIdx.x; asm volatile("" : "+v"(tid_)); const int tid = tid_, wid = __builtin_amdgcn_readfirstlane(tid >> 6), lane = tid & 63, wr = wid >> 2, wc = wid & 3, fr = lane & 15, fq = lane >> 4;
    const int K = g.K, nt = K / BK;
    unsigned voffA[2], voffB[2];
#pragma unroll
    for (int i = 0; i < 2; ++i) { int R, C; stage_rc(tid * 16 + i * 8192, R, C); const int Rb = Epi::PERM ? ((R & ~31) + perm32(R & 31)) : R;
        voffA[i] = (unsigned)(R * K + C) * 2u; voffB[i] = (unsigned)(Rb * K + C) * 2u; }
    const size_t kstep = (size_t)(BK * 2);
    const size_t hstep = (size_t)HALF * K * 2;
    const size_t tstep = 2 * hstep;
    const unsigned ldsw = (unsigned)wid * 1024u;
    const int aoff = lds_byte(wr * 64 + fr, fq * 8), boff = lds_byte(wc * 32 + fr, fq * 8);
#define PG8_SA(b, h) (((b) * 2 + (h)) * HTB)
#define PG8_SB(b, h) ((4 + (b) * 2 + (h)) * HTB)
#define PG8_STAGE(bufoff, gbase, voff) do { _Pragma("unroll") for (int _i = 0; _i < 2; ++_i) \
        __builtin_amdgcn_global_load_lds((const unsigned*)((const char*)(gbase) + (voff)[_i]), (PG8_LAS unsigned*)(lds + (bufoff) + ldsw + _i * 8192), 16, 0, 0); } while (0)
#define PG8_LDA(dst, b, h) do { _Pragma("unroll") for (int m = 0; m < 4; ++m) _Pragma("unroll") for (int k = 0; k < 2; ++k) dst[m][k] = *(const PG8_LAS bf16x8*)(lds + PG8_SA(b, h) + aoff + m * 2048 + k * 1024); } while (0)
#define PG8_LDB(dst, b, h) do { _Pragma("unroll") for (int n = 0; n < 2; ++n) _Pragma("unroll") for (int k = 0; k < 2; ++k) dst[n][k] = *(const PG8_LAS bf16x8*)(lds + PG8_SB(b, h) + boff + n * 2048 + k * 1024); } while (0)
#define PG8_MMA(ai, bj, At, Bt) do { __builtin_amdgcn_s_setprio(1); _Pragma("unroll") for (int m = 0; m < 4; ++m) _Pragma("unroll") for (int n = 0; n < 2; ++n) _Pragma("unroll") for (int k = 0; k < 2; ++k) \
        acc[ai][bj][m][n] = __builtin_amdgcn_mfma_f32_16x16x32_bf16(Bt[n][k], At[m][k], acc[ai][bj][m][n], 0, 0, 0); __builtin_amdgcn_s_setprio(0); } while (0)
#define PG8_WAIT_V(n) asm volatile("s_waitcnt vmcnt(" #n ")" ::: "memory")
#define PG8_WAIT_L(n) asm volatile("s_waitcnt lgkmcnt(" #n ")" ::: "memory")
#define PG8_BAR __builtin_amdgcn_s_barrier()
#define PG8_SCHED __builtin_amdgcn_sched_barrier(0)
    Unit cur, nxt; int ui = 0;
    if (!S.next(0, cur)) return;
    f32x4 acc[2][2][4][2];
#pragma unroll
    for (int a = 0; a < 2; ++a)
#pragma unroll
        for (int b = 0; b < 2; ++b)
#pragma unroll
            for (int m = 0; m < 4; ++m)
#pragma unroll
                for (int n = 0; n < 2; ++n) acc[a][b][m][n] = (f32x4){0.f, 0.f, 0.f, 0.f};
    bf16x8 At[4][2], B0[2][2], B1[2][2];
    const char* cA = (const char*)g.A + (size_t)cur.pm * tstep; const char* cB = (const char*)g.Bt + (size_t)cur.pn * tstep;
    S.a_ready(cur);
    if constexpr (SP2) {
        PG8_STAGE(PG8_SB(0, 0), cB, voffB); PG8_STAGE(PG8_SB(0, 1), cB + hstep, voffB); PG8_STAGE(PG8_SA(0, 0), cA, voffA); PG8_STAGE(PG8_SA(0, 1), cA + hstep, voffA);
        if (wr == 1) PG8_BAR;
        PG8_WAIT_V(2); PG8_BAR;
        PG8_STAGE(PG8_SB(1, 0), cB + kstep, voffB); PG8_STAGE(PG8_SA(1, 0), cA + kstep, voffA); PG8_STAGE(PG8_SB(1, 1), cB + hstep + kstep, voffB);
        PG8_WAIT_V(6); PG8_BAR;
    } else {
        PG8_STAGE(PG8_SB(0, 0), cB, voffB); PG8_STAGE(PG8_SA(0, 0), cA, voffA); PG8_STAGE(PG8_SB(0, 1), cB + hstep, voffB); PG8_STAGE(PG8_SA(0, 1), cA + hstep, voffA);
        if (wr == 1) PG8_BAR;
        PG8_WAIT_V(4); PG8_BAR;
        PG8_STAGE(PG8_SB(1, 0), cB + kstep, voffB); PG8_STAGE(PG8_SA(1, 0), cA + kstep, voffA); PG8_STAGE(PG8_SB(1, 1), cB + hstep + kstep, voffB);
        PG8_WAIT_V(6); PG8_BAR;
    }
    for (;;) {
        const bool has_next = S.next(ui + 1, nxt);
        const char* nA = has_next ? (const char*)g.A + (size_t)nxt.pm * tstep : cA; const char* nB = has_next ? (const char*)g.Bt + (size_t)nxt.pn * tstep : cB;
        for (int t = 0; t < nt; t += 2) {
            const bool last = (t == nt - 2);
            const char* a1 = cA + (size_t)(t + 1) * kstep;
            const char* a2 = last ? nA : cA + (size_t)(t + 2) * kstep; const char* b2 = last ? nB : cB + (size_t)(t + 2) * kstep;
            const char* a3 = a2 + kstep; const char* b3 = b2 + kstep;
            if (last && has_next) S.a_ready(nxt);
            if constexpr (SP2) {
            PG8_LDB(B0, 0, 0); PG8_LDB(B1, 0, 1); PG8_SCHED; PG8_LDA(At, 0, 0); PG8_STAGE(PG8_SA(1, 1), a1 + hstep, voffA);
            PG8_WAIT_V(8); PG8_WAIT_L(0); PG8_BAR; PG8_MMA(0, 0, At, B0); PG8_MMA(0, 1, At, B1); PG8_BAR; PG8_SCHED;
            PG8_LDA(At, 0, 1); PG8_STAGE(PG8_SB(0, 0), b2, voffB); PG8_STAGE(PG8_SB(0, 1), b2 + hstep, voffB); PG8_STAGE(PG8_SA(0, 0), a2, voffA);
            PG8_WAIT_V(8); PG8_WAIT_L(0); PG8_BAR; PG8_MMA(1, 0, At, B0); PG8_MMA(1, 1, At, B1); PG8_BAR; PG8_SCHED;
            PG8_LDB(B0, 1, 0); PG8_LDB(B1, 1, 1); PG8_SCHED; PG8_LDA(At, 1, 0); PG8_STAGE(PG8_SA(0, 1), a2 + hstep, voffA);
            PG8_WAIT_V(8); PG8_WAIT_L(0); PG8_BAR; PG8_MMA(0, 0, At, B0); PG8_MMA(0, 1, At, B1); PG8_BAR; PG8_SCHED;
            PG8_LDA(At, 1, 1); PG8_STAGE(PG8_SB(1, 0), b3, voffB); PG8_STAGE(PG8_SB(1, 1), b3 + hstep, voffB); PG8_STAGE(PG8_SA(1, 0), a3, voffA);
            PG8_WAIT_V(8); PG8_WAIT_L(0); PG8_BAR; PG8_MMA(1, 0, At, B0); PG8_MMA(1, 1, At, B1); PG8_BAR; PG8_SCHED;
            } else {
            PG8_LDB(B0, 0, 0); PG8_SCHED; PG8_LDA(At, 0, 0); PG8_STAGE(PG8_SA(1, 1), a1 + hstep, voffA);
            PG8_WAIT_L(8); PG8_BAR; PG8_WAIT_L(0); PG8_MMA(0, 0, At, B0); PG8_BAR; PG8_SCHED;
            PG8_LDB(B1, 0, 1); PG8_STAGE(PG8_SB(0, 0), b2, voffB);
            PG8_BAR; PG8_WAIT_L(0); PG8_MMA(0, 1, At, B1); PG8_BAR;
            PG8_LDA(At, 0, 1); PG8_STAGE(PG8_SA(0, 0), a2, voffA);
            PG8_BAR; PG8_WAIT_L(0); PG8_MMA(1, 0, At, B0); PG8_BAR; PG8_SCHED;
            PG8_STAGE(PG8_SB(0, 1), b2 + hstep, voffB);
            PG8_WAIT_V(6); PG8_BAR; PG8_MMA(1, 1, At, B1); PG8_BAR;
            PG8_LDB(B0, 1, 0); PG8_SCHED; PG8_LDA(At, 1, 0); PG8_STAGE(PG8_SA(0, 1), a2 + hstep, voffA);
            PG8_WAIT_L(8); PG8_BAR; PG8_WAIT_L(0); PG8_MMA(0, 0, At, B0); PG8_BAR; PG8_SCHED;
            PG8_LDB(B1, 1, 1); PG8_STAGE(PG8_SB(1, 0), b3, voffB);
            PG8_BAR; PG8_WAIT_L(0); PG8_MMA(0, 1, At, B1); PG8_BAR;
            PG8_LDA(At, 1, 1); PG8_STAGE(PG8_SA(1, 0), a3, voffA);
            PG8_BAR; PG8_WAIT_L(0); PG8_MMA(1, 0, At, B0); PG8_BAR; PG8_SCHED;
            PG8_STAGE(PG8_SB(1, 1), b3 + hstep, voffB);
            PG8_WAIT_V(6); PG8_BAR; PG8_MMA(1, 1, At, B1); PG8_BAR;
            }
        }
        if constexpr (ALIGN_EPI) { if (wr == 0) PG8_BAR; }
        if constexpr (!Epi::AFTER_DRAIN) { E(acc, cur, wr, wc, fr, fq); S.done(cur); }
        if (!has_next) break;
#pragma unroll
        for (int a = 0; a < 2; ++a)
#pragma unroll
            for (int b = 0; b < 2; ++b)
#pragma unroll
                for (int m = 0; m < 4; ++m)
#pragma unroll
                    for (int n = 0; n < 2; ++n) acc[a][b][m][n] = (f32x4){0.f, 0.f, 0.f, 0.f};
        cur = nxt; cA = nA; cB = nB; ++ui;
        if constexpr (ALIGN_EPI) { if (wr == 1) PG8_BAR; }
    }
    PG8_WAIT_V(0);
    if constexpr (!ALIGN_EPI) { if (wr == 0) PG8_BAR; }
    PG8_BAR;
    if constexpr (Epi::AFTER_DRAIN) { E.fused(acc, cur, wr, wc, fr, fq, lds, wid, lane); S.done(cur); }
#undef PG8_SA
#undef PG8_SB
#undef PG8_STAGE
#undef PG8_LDA
#undef PG8_LDB
#undef PG8_MMA
#undef PG8_WAIT_V
#undef PG8_WAIT_L
#undef PG8_BAR
#undef PG8_SCHED
}
}

#ifndef PH_MASK
#define PH_MASK 0xFFFFFFFFu
#endif
#define PHON(i) ((PH_MASK >> (i)) & 1u)
#ifndef REP_DSA
#define REP_DSA 1
#endif
#ifndef REP_DIFF
#define REP_DIFF 1
#endif
#ifndef REP_DIL
#define REP_DIL 1
#endif
#ifndef REP_SWI
#define REP_SWI 1
#endif
#ifndef REP_SYNC
#define REP_SYNC 0
#endif
#ifndef REP_PREP
#define REP_PREP 1
#endif
#ifndef DSA_REP_IDX
#define DSA_REP_IDX 1
#endif
#ifndef DSA_REP_TOPK
#define DSA_REP_TOPK 1
#endif
#ifndef DSA_REP_ATT
#define DSA_REP_ATT 1
#endif
#ifndef MK_ONE_LAUNCH
#define MK_ONE_LAUNCH 1
#endif
#define LAS __attribute__((address_space(3)))
typedef unsigned short bf16_t;
typedef short bf16x8 __attribute__((ext_vector_type(8)));
typedef short s16x4 __attribute__((ext_vector_type(4)));
typedef short v4i16_t __attribute__((ext_vector_type(4)));
typedef float f32x4 __attribute__((ext_vector_type(4)));
typedef float f32x16 __attribute__((ext_vector_type(16)));
typedef unsigned u32x4 __attribute__((ext_vector_type(4)));
typedef unsigned u32x2 __attribute__((ext_vector_type(2)));

constexpr int NB = 8, T = 2048, D = 1024, M = NB * T, FF = 2816, NGU = 2 * FF, PLE = 256;
constexpr int EVEN_N = 2816, ODD_N = 3072, EVEN_SRC = 2760;
constexpr int NWAVES = 8, NTHR = 512, LDS_BYTES = 147456;
constexpr size_t MiB = 1u << 20;
constexpr size_t WS_SSQ = 0;
constexpr size_t WS_BAR = 1216 * 1024, BAR_BYTES = 32768;
constexpr int LDS_MISC = LDS_BYTES - 256;
constexpr size_t WS_COS = 1280 * 1024, WS_SIN = WS_COS + 256 * 1024;
constexpr size_t WS_W = 2 * MiB;
constexpr size_t SZ_GU = (size_t)NGU * D * 2, SZ_WD = (size_t)D * FF * 2, SZ_FFN = 2 * (SZ_GU + SZ_WD);
constexpr size_t WS_FFN0 = WS_W, WS_FFN1 = WS_FFN0 + SZ_FFN;
constexpr size_t WS_PG = WS_FFN1 + SZ_FFN;
constexpr size_t WS_PP = WS_PG + 2 * (size_t)D * D * 2;
constexpr size_t WS_WIN_E = WS_PP + 2 * (size_t)D * PLE * 2;
constexpr size_t WS_WIN_O = WS_WIN_E + (size_t)EVEN_N * D * 2;
constexpr size_t WS_WOUT_E = WS_WIN_O + (size_t)ODD_N * D * 2;
constexpr size_t WS_WOUT_O = WS_WOUT_E + (size_t)D * D * 2;
constexpr size_t WS_WEND = WS_WOUT_O + (size_t)D * D * 2;
constexpr size_t WS_HBA = 89 * MiB;
constexpr size_t WS_HBB = 217 * MiB;
constexpr size_t WS_BIG = 121 * MiB;
constexpr size_t WS_MRG = 217 * MiB;
constexpr size_t WS_PBF = 249 * MiB;
constexpr size_t WS_END = 265 * MiB;
static_assert(WS_WEND <= WS_HBA && SZ_FFN >= (size_t)M * D * 2, "ws map");

using pg8::cvt_pk_bf16;
__device__ __forceinline__ float bf2f(bf16_t b) { return __uint_as_float(((unsigned)b) << 16); }
__device__ __forceinline__ int crow(int r, int hi) { return (r & 3) + 8 * (r >> 2) + 4 * hi; }
__device__ __forceinline__ s16x4 vtr(const LAS unsigned char* p) { return __builtin_bit_cast(s16x4, __builtin_amdgcn_ds_read_tr16_b64_v4i16((LAS v4i16_t*)p)); }
__device__ __forceinline__ float wave_sum(float v) {
#pragma unroll
    for (int o = 1; o < 64; o <<= 1) v += __shfl_xor(v, o);
    return v;
}
typedef float f32x2_t __attribute__((ext_vector_type(2))); typedef __bf16 bf16x2_t __attribute__((ext_vector_type(2)));
__device__ __forceinline__ unsigned cvtpk_c(float lo, float hi) { f32x2_t v = {lo, hi}; bf16x2_t b = __builtin_convertvector(v, bf16x2_t); return __builtin_bit_cast(unsigned, b); }
__device__ __forceinline__ bf16x8 pack8(float a0, float a1, float a2, float a3, float a4, float a5, float a6, float a7) {
    u32x4 w; w.x = cvtpk_c(a0, a1); w.y = cvtpk_c(a2, a3); w.z = cvtpk_c(a4, a5); w.w = cvtpk_c(a6, a7); return __builtin_bit_cast(bf16x8, w);
}
__device__ __forceinline__ f32x16 zero16() { f32x16 z = f32x16{}; asm volatile("" : "+v"(z)); return z; }
#define MFMA32(a, b, c) __builtin_amdgcn_mfma_f32_32x32x16_bf16((a), (b), (c), 0, 0, 0)
#define MFMA16(a, b, c) __builtin_amdgcn_mfma_f32_16x16x32_bf16((a), (b), (c), 0, 0, 0)

template <int NDT>
__device__ __forceinline__ void softmax_tile(f32x16& p, const f32x16& w, float& m, float& l, f32x16 (&o)[NDT], LAS float* wsf, int r32, int hi, bf16x8& pa0, bf16x8& pa1) {
    float tmax = -1e30f;
#pragma unroll
    for (int r = 0; r < 16; ++r) tmax = fmaxf(tmax, w[r] > 0.f ? p[r] : -1e30f);
    tmax = fmaxf(tmax, __shfl_xor(tmax, 32));
    const float mn = fmaxf(m, tmax), alpha = __builtin_amdgcn_exp2f(m - mn); m = mn;
    float rs = 0.f;
#pragma unroll
    for (int r = 0; r < 16; ++r) { p[r] = __builtin_amdgcn_exp2f(fminf(p[r] - mn, 0.f)) * w[r]; rs += p[r]; }
    l = l * alpha + rs;
    if (__any(alpha != 1.0f)) {
        if (hi == 0) wsf[r32] = alpha;
#pragma unroll
        for (int a = 0; a < 4; ++a) { const f32x4 al = *(const LAS f32x4*)(wsf + 8 * a + 4 * hi);
#pragma unroll
            for (int dt = 0; dt < NDT; ++dt) { o[dt][4 * a + 0] *= al[0]; o[dt][4 * a + 1] *= al[1]; o[dt][4 * a + 2] *= al[2]; o[dt][4 * a + 3] *= al[3]; } }
    }
    pa0 = pack8(p[0], p[1], p[2], p[3], p[4], p[5], p[6], p[7]);
    pa1 = pack8(p[8], p[9], p[10], p[11], p[12], p[13], p[14], p[15]);
}
template <int NDT>
__device__ __forceinline__ void softmax_tile_lw(f32x16& p, const f32x16& lw, float& m, float& l, f32x16 (&o)[NDT], LAS float* wsf, int r32, int hi, bf16x8& pa0, bf16x8& pa1) {
    float tmax = -1e30f;
#pragma unroll
    for (int r = 0; r < 16; ++r) { p[r] += lw[r]; tmax = fmaxf(tmax, p[r]); }
    tmax = fmaxf(tmax, __shfl_xor(tmax, 32));
    const float mn = fmaxf(m, tmax), alpha = __builtin_amdgcn_exp2f(m - mn); m = mn;
    float rs = 0.f;
#pragma unroll
    for (int r = 0; r < 16; ++r) { p[r] = __builtin_amdgcn_exp2f(p[r] - mn); rs += p[r]; }
    l = l * alpha + rs;
    if (__any(alpha != 1.0f)) {
        if (hi == 0) wsf[r32] = alpha;
#pragma unroll
        for (int a = 0; a < 4; ++a) { const f32x4 al = *(const LAS f32x4*)(wsf + 8 * a + 4 * hi);
#pragma unroll
            for (int dt = 0; dt < NDT; ++dt) { o[dt][4 * a + 0] *= al[0]; o[dt][4 * a + 1] *= al[1]; o[dt][4 * a + 2] *= al[2]; o[dt][4 * a + 3] *= al[3]; } }
    }
    pa0 = pack8(p[0], p[1], p[2], p[3], p[4], p[5], p[6], p[7]);
    pa1 = pack8(p[8], p[9], p[10], p[11], p[12], p[13], p[14], p[15]);
}
template <int NDT>
__device__ __forceinline__ void softmax_finish(float l, f32x16 (&o)[NDT], LAS float* wsf, int r32, int hi) {
    l += __shfl_xor(l, 32);
    if (hi == 0) wsf[r32] = 1.0f / l;
#pragma unroll
    for (int a = 0; a < 4; ++a) { const f32x4 al = *(const LAS f32x4*)(wsf + 8 * a + 4 * hi);
#pragma unroll
        for (int dt = 0; dt < NDT; ++dt) { o[dt][4 * a + 0] *= al[0]; o[dt][4 * a + 1] *= al[1]; o[dt][4 * a + 2] *= al[2]; o[dt][4 * a + 3] *= al[3]; } }
}

constexpr int EV_QA = 0, EV_QI = 512, EV_QB = 1024, EV_KB = 1536, EV_KA = 2048, EV_KI = 2112, EV_VA = 2176, EV_WI = 2240, EV_VB = 2304;
__device__ __forceinline__ void diff_unit(LAS unsigned char* lds, const bf16_t* proj, bf16_t* merged, const float* subln, float lam, int b, int hb, int qb, int tid, int wid, int lane) {
    const int r32 = lane & 31, hi = lane >> 5, comp = wid >> 2, qsub = wid & 3;
    const int qpos = qb * 128 + qsub * 32 + r32;
    const size_t rowb = (size_t)b * T;
    LAS float* wsf = (LAS float*)(lds + 65536 + wid * 256);
    bf16x8 qf[4];
    { const bf16_t* qp = proj + (rowb + qpos) * EVEN_N + EV_QB + 64 * (2 * hb + comp) + 8 * hi;
#pragma unroll
      for (int ks = 0; ks < 4; ++ks) qf[ks] = *(const bf16x8*)(qp + 16 * ks); }
    f32x16 o[4];
#pragma unroll
    for (int dt = 0; dt < 4; ++dt) o[dt] = f32x16{};
    float m = -1e29f, l = 0.f;
    const int nt = 4 * (qb + 1);
    const int kcomp = tid >> 8, kkey = (tid >> 3) & 31, kch = tid & 7, vkey = tid >> 4, vch = tid & 15;
    const bf16_t* kg = proj + (rowb + kkey) * EVEN_N + EV_KB + 64 * (2 * hb + kcomp) + 8 * kch;
    const bf16_t* vg = proj + (rowb + vkey) * EVEN_N + EV_VB + 128 * hb + 8 * vch;
    const int kdst = kcomp * 4096 + kkey * 128 + 16 * (kch ^ ((kkey >> 1) & 7));
    const int vdst = 8192 + vkey * 256 + 16 * (vch ^ ((vkey & 3) << 2));
    u32x4 kreg = *(const u32x4*)kg, vreg = *(const u32x4*)vg;
    const int qq = (lane & 15) >> 2, pp_ = lane & 3, g1 = (lane >> 4) & 1;
    for (int t = 0; t < nt; ++t) {
        const int buf = (t & 1) * 16384;
        *(LAS u32x4*)(lds + buf + kdst) = kreg; *(LAS u32x4*)(lds + buf + vdst) = vreg;
        __syncthreads();
        if (t + 1 < nt) { kreg = *(const u32x4*)(kg + (size_t)(t + 1) * 32 * EVEN_N); vreg = *(const u32x4*)(vg + (size_t)(t + 1) * 32 * EVEN_N); }
        if (32 * t <= qb * 128 + qsub * 32 + 31) {
            f32x16 p = zero16();
#pragma unroll
            for (int ks = 0; ks < 4; ++ks) { const bf16x8 kf = *(const LAS bf16x8*)(lds + buf + comp * 4096 + r32 * 128 + 16 * ((2 * ks + hi) ^ ((r32 >> 1) & 7))); p = MFMA32(kf, qf[ks], p); }
            f32x16 w;
#pragma unroll
            for (int r = 0; r < 16; ++r) w[r] = (32 * t + crow(r, hi) <= qpos) ? 0.f : -1e30f;
            bf16x8 pa[2];
            softmax_tile_lw<4>(p, w, m, l, o, wsf, r32, hi, pa[0], pa[1]);
#pragma unroll
            for (int s = 0; s < 2; ++s)
#pragma unroll
                for (int dt = 0; dt < 4; ++dt) { const int row = 16 * s + 4 * hi + qq, c = 4 * dt + 2 * g1 + (pp_ >> 1);
                    const s16x4 lo = vtr(lds + buf + 8192 + row * 256 + 16 * (c ^ (qq << 2)) + 8 * (pp_ & 1));
                    const s16x4 h4 = vtr(lds + buf + 8192 + (row + 8) * 256 + 16 * (c ^ (qq << 2)) + 8 * (pp_ & 1));
                    const bf16x8 bv = (bf16x8){lo[0], lo[1], lo[2], lo[3], h4[0], h4[1], h4[2], h4[3]};
                    o[dt] = MFMA32(pa[s], bv, o[dt]); }
        }
    }
    softmax_finish<4>(l, o, wsf, r32, hi);
    __syncthreads();
    LAS float* xb = (LAS float*)lds;
    if (comp == 1) {
#pragma unroll
        for (int dt = 0; dt < 4; ++dt)
#pragma unroll
            for (int r = 0; r < 16; ++r) xb[(qsub * 32 + crow(r, hi)) * 128 + 32 * dt + r32] = o[dt][r];
    }
    __syncthreads();
    if (comp == 0) {
        float g[4];
#pragma unroll
        for (int dt = 0; dt < 4; ++dt) g[dt] = subln[32 * dt + r32] * 0.8f;
#pragma unroll
        for (int r = 0; r < 16; ++r) { float ss = 0.f;
#pragma unroll
            for (int dt = 0; dt < 4; ++dt) { o[dt][r] -= lam * xb[(qsub * 32 + crow(r, hi)) * 128 + 32 * dt + r32]; ss += o[dt][r] * o[dt][r]; }
            ss += __shfl_xor(ss, 1); ss += __shfl_xor(ss, 2); ss += __shfl_xor(ss, 4); ss += __shfl_xor(ss, 8); ss += __shfl_xor(ss, 16);
            const float rs = rsqrtf(ss * (1.0f / 128.0f) + 1e-5f);
            bf16_t* op = merged + (rowb + qb * 128 + qsub * 32 + crow(r, hi)) * D + 512 + 128 * hb + r32;
#pragma unroll
            for (int dt = 0; dt < 4; ++dt) op[32 * dt] = (bf16_t)(cvtpk_c(o[dt][r] * rs * g[dt], 0.f) & 0xffffu); }
    }
    __syncthreads();
}

__device__ __forceinline__ int swz16(int k) { return ((k & 3) << 2) | ((k >> 2) & 3); }
__device__ __forceinline__ void dil_unit(LAS unsigned char* lds, const bf16_t* proj, bf16_t* merged, int b, int hp, int qb, int tid, int wid, int lane) {
    const int r32 = lane & 31, hi = lane >> 5, hsel = wid >> 2, cls = wid & 3, head = 2 * hp + hsel;
    const int P0 = 128 * qb, qpos = P0 + cls + 4 * r32;
    const size_t rowb = (size_t)b * T;
    LAS float* wsf = (LAS float*)(lds + 131072 + wid * 256);
    bf16x8 qf[4];
    { const bf16_t* qp = proj + (rowb + qpos) * ODD_N + 64 * head + 8 * hi;
#pragma unroll
      for (int ks = 0; ks < 4; ++ks) qf[ks] = *(const bf16x8*)(qp + 16 * ks); }
    f32x16 o[2]; o[0] = f32x16{}; o[1] = f32x16{};
    float m = -1e29f, l = 0.f;
    const int lpos = tid >> 4, lcc = tid & 15;
    const bf16_t* gsrc = proj + (rowb + lpos) * ODD_N + 1024 + 128 * hp + 8 * lcc;
    u32x4 pre[8];
#pragma unroll
    for (int i = 0; i < 8; ++i) pre[i] = *(const u32x4*)(gsrc + (size_t)(32 * (i & 3)) * ODD_N + (i >> 2) * 1024);
    const int qq = (lane & 15) >> 2, pp_ = lane & 3, g1 = (lane >> 4) & 1;
    for (int c = 0; c <= qb; ++c) {
        LAS unsigned char* lb = lds + (c & 1) * 65536;
#pragma unroll
        for (int i = 0; i < 8; ++i) { const int pos = lpos + 32 * (i & 3); *(LAS u32x4*)(lb + (i >> 2) * 32768 + pos * 256 + 16 * (lcc ^ swz16(pos >> 2))) = pre[i]; }
        __syncthreads();
        if (c < qb) {
#pragma unroll
            for (int i = 0; i < 8; ++i) pre[i] = *(const u32x4*)(gsrc + (size_t)(128 * (c + 1) + 32 * (i & 3)) * ODD_N + (i >> 2) * 1024);
        }
        const int dist = qb - c;
        for (int j = 0; j < 4; ++j) {
            if (j == cls || dist <= 1) {
                f32x16 p = zero16();
#pragma unroll
                for (int ks = 0; ks < 4; ++ks) { const bf16x8 kf = *(const LAS bf16x8*)(lb + (4 * r32 + j) * 256 + 16 * ((8 * hsel + 2 * ks + hi) ^ swz16(r32))); p = MFMA32(kf, qf[ks], p); }
                f32x16 w; const int d0 = qpos - (128 * c + j) - 16 * hi;
                float A4[4];
#pragma unroll
                for (int k = 0; k < 4; ++k) A4[k] = (((d0 - 4 * k) & 15) == 0) ? 1.f : 0.f;
                const float NEG = -1e30f, L3 = 1.5849625007211562f;
                if (j == cls) {
                    if (dist >= 5) {
#pragma unroll
                        for (int r = 0; r < 16; ++r) w[r] = A4[r & 3] > 0.f ? 0.f : NEG;
                    } else if (dist == 4) {
#pragma unroll
                        for (int r = 0; r < 16; ++r) { const bool c5 = (d0 - 4 * (r & 3) - 32 * (r >> 2)) <= 512; w[r] = A4[r & 3] > 0.f ? (c5 ? 1.f : 0.f) : (c5 ? 0.f : NEG); }
                    } else if (dist >= 2) {
#pragma unroll
                        for (int r = 0; r < 16; ++r) w[r] = A4[r & 3];
                    } else if (dist == 1) {
#pragma unroll
                        for (int r = 0; r < 16; ++r) { const bool c1 = (d0 - 4 * (r & 3) - 32 * (r >> 2)) <= 128; w[r] = A4[r & 3] > 0.f ? (c1 ? L3 : 1.f) : (c1 ? 1.f : 0.f); }
                    } else {
#pragma unroll
                        for (int r = 0; r < 16; ++r) { const bool g0 = (d0 - 4 * (r & 3) - 32 * (r >> 2)) >= 0; w[r] = g0 ? (A4[r & 3] > 0.f ? L3 : 1.f) : NEG; }
                    }
                } else if (dist == 1) {
#pragma unroll
                    for (int r = 0; r < 16; ++r) w[r] = ((d0 - 4 * (r & 3) - 32 * (r >> 2)) <= 128) ? 0.f : NEG;
                } else {
#pragma unroll
                    for (int r = 0; r < 16; ++r) w[r] = ((d0 - 4 * (r & 3) - 32 * (r >> 2)) >= 0) ? 0.f : NEG;
                }
                bf16x8 pa[2];
                softmax_tile_lw<2>(p, w, m, l, o, wsf, r32, hi, pa[0], pa[1]);
#pragma unroll
                for (int s = 0; s < 2; ++s)
#pragma unroll
                    for (int dt = 0; dt < 2; ++dt) { const int kap = 16 * s + 4 * hi + qq, cc = 8 * hsel + 4 * dt + 2 * g1 + (pp_ >> 1);
                        const s16x4 lo = vtr(lb + 32768 + (4 * kap + j) * 256 + 16 * (cc ^ swz16(kap)) + 8 * (pp_ & 1));
                        const s16x4 h4 = vtr(lb + 32768 + (4 * (kap + 8) + j) * 256 + 16 * (cc ^ swz16(kap + 8)) + 8 * (pp_ & 1));
                        const bf16x8 bv = (bf16x8){lo[0], lo[1], lo[2], lo[3], h4[0], h4[1], h4[2], h4[3]};
                        o[dt] = MFMA32(pa[s], bv, o[dt]); }
            }
        }
    }
    softmax_finish<2>(l, o, wsf, r32, hi);
#pragma unroll
    for (int r = 0; r < 16; ++r) { bf16_t* op = merged + (rowb + P0 + cls + 4 * crow(r, hi)) * D + 64 * head + r32;
        op[0] = (bf16_t)(cvtpk_c(o[0][r], 0.f) & 0xffffu); op[32] = (bf16_t)(cvtpk_c(o[1][r], 0.f) & 0xffffu); }
}

constexpr int DSA_WQ = 131072, DSA_SEL = 131584;
__device__ __forceinline__ unsigned mono_key(float f) { unsigned u = __float_as_uint(f); if (u == 0x80000000u) u = 0u; return (u & 0x80000000u) ? ~u : (u | 0x80000000u); }
__device__ __forceinline__ void dsa_unit(LAS unsigned char* lds, const bf16_t* proj, bf16_t* merged, int b, int qblk, int tid, int wid, int lane) {
    asm volatile("" : "+v"(lane), "+v"(tid));
    const int r32 = lane & 31, hi = lane >> 5, t0 = 16 * qblk;
    const size_t rowb = (size_t)b * T;
    LAS float* isc = (LAS float*)lds;
    LAS float* wq = (LAS float*)(lds + DSA_WQ);
    LAS unsigned short* sel = (LAS unsigned short*)(lds + DSA_SEL);
    if (tid < 128) wq[tid] = bf2f(proj[(rowb + t0 + (tid >> 3)) * EVEN_N + EV_WI + (tid & 7)]);
    for (int rep_i = 0; rep_i < DSA_REP_IDX; ++rep_i) {
    {
        bf16x8 af[4][4];
#pragma unroll
        for (int mt = 0; mt < 4; ++mt) { const int ql = 4 * mt + 2 * (r32 >> 4) + ((r32 >> 2) & 1), hd = 4 * ((r32 >> 3) & 1) + (r32 & 3);
            const bf16_t* ap = proj + (rowb + t0 + ql) * EVEN_N + EV_QI + 64 * hd + 8 * hi;
#pragma unroll
            for (int ks = 0; ks < 4; ++ks) af[mt][ks] = *(const bf16x8*)(ap + 16 * ks); }
        __syncthreads();
        const int nkt = (t0 + 16 + 31) >> 5;
        bf16x8 bnx[4];
        { const int kt0 = wid < nkt ? wid : 0; const bf16_t* bp = proj + (rowb + 32 * kt0 + r32) * EVEN_N + EV_KI + 8 * hi;
#pragma unroll
          for (int ks = 0; ks < 4; ++ks) bnx[ks] = *(const bf16x8*)(bp + 16 * ks); }
        for (int kt = wid; kt < nkt; kt += NWAVES) {
            bf16x8 bfr[4];
#pragma unroll
            for (int ks = 0; ks < 4; ++ks) bfr[ks] = bnx[ks];
            { const int ktn = (kt + NWAVES < nkt) ? kt + NWAVES : kt; const bf16_t* bp = proj + (rowb + 32 * ktn + r32) * EVEN_N + EV_KI + 8 * hi;
#pragma unroll
              for (int ks = 0; ks < 4; ++ks) bnx[ks] = *(const bf16x8*)(bp + 16 * ks); }
            const int key = 32 * kt + r32;
#pragma unroll
            for (int mt = 0; mt < 4; ++mt) { f32x16 acc = zero16();
#pragma unroll
                for (int ks = 0; ks < 4; ++ks) acc = MFMA32(af[mt][ks], bfr[ks], acc);
#pragma unroll
                for (int b4 = 0; b4 < 2; ++b4) { const int ql = 4 * mt + 2 * b4 + hi;
                    const f32x4 w0 = *(const LAS f32x4*)(wq + ql * 8), w1 = *(const LAS f32x4*)(wq + ql * 8 + 4);
                    float sc = w0[0] * fmaxf(acc[8 * b4 + 0], 0.f) + w0[1] * fmaxf(acc[8 * b4 + 1], 0.f) + w0[2] * fmaxf(acc[8 * b4 + 2], 0.f) + w0[3] * fmaxf(acc[8 * b4 + 3], 0.f)
                             + w1[0] * fmaxf(acc[8 * b4 + 4], 0.f) + w1[1] * fmaxf(acc[8 * b4 + 5], 0.f) + w1[2] * fmaxf(acc[8 * b4 + 6], 0.f) + w1[3] * fmaxf(acc[8 * b4 + 7], 0.f);
                    isc[ql * 2048 + key] = sc; } }
        }
    }
    __syncthreads();
    }
    for (int rep_t = 0; rep_t < DSA_REP_TOPK; ++rep_t) {
    int lane1 = lane; asm volatile("" : "+v"(lane1));
#pragma unroll
    for (int qi2 = 0; qi2 < 2; ++qi2) {
        const int ql = 2 * wid + qi2, t = t0 + ql, n = t + 1;
        if (n <= 256) {
#pragma unroll
            for (int j = 0; j < 4; ++j) sel[ql * 256 + lane1 + 64 * j] = (unsigned short)(lane1 + 64 * j);
        } else {
            unsigned kv[32];
#pragma unroll
            for (int j = 0; j < 32; ++j) { const int s = lane1 + 64 * j; kv[j] = (s < n) ? mono_key(isc[ql * 2048 + (s < 2048 ? s : 0)]) : 0u; }
            unsigned thr = 0u;
            const int ng = (n + 511) >> 9;
            for (int bit = 31; bit >= 0; --bit) { const unsigned cand = thr | (1u << bit); int cnt = 0;
#pragma unroll
                for (int g8 = 0; g8 < 4; ++g8) { if (g8 < ng) {
#pragma unroll
                    for (int j = 8 * g8; j < 8 * g8 + 8; ++j) cnt += __popcll(__ballot(kv[j] >= cand)); } }
                if (cnt >= 256) thr = cand;
                if (cnt == 256) break; }
            int cgt = 0;
#pragma unroll
            for (int j = 0; j < 32; ++j) cgt += __popcll(__ballot(kv[j] > thr));
            const int need = 256 - cgt;
            const unsigned long long ltmask = (1ull << lane1) - 1ull;
            int beq = 0, bsel = 0;
#pragma unroll
            for (int j = 0; j < 32; ++j) { const bool eq = kv[j] == thr; const unsigned long long em = __ballot(eq);
                const int rk = beq + __popcll(em & ltmask); beq += __popcll(em);
                const bool take = (kv[j] > thr) || (eq && rk < need);
                const unsigned long long sm = __ballot(take); const int pos = bsel + __popcll(sm & ltmask); bsel += __popcll(sm);
                if (take) sel[ql * 256 + pos] = (unsigned short)(lane1 + 64 * j); }
        }
    }
    }
    for (int rep_a = 0; rep_a < DSA_REP_ATT; ++rep_a) {
    LAS unsigned char* vst = lds + (2 * wid) * 8192;
#pragma unroll 1
    for (int qi2 = 0; qi2 < 2; ++qi2) {
        int lane2 = lane; asm volatile("" : "+v"(lane2));
        const int n15 = lane2 & 15, kg = lane2 >> 4, qq = n15 >> 2, pp_ = lane2 & 3;
        const int ql = 2 * wid + qi2, t = t0 + ql, nsel = (t + 1 < 256) ? t + 1 : 256;
        bf16x8 qb0, qb1;
        { const bf16_t* qp = proj + (rowb + t) * EVEN_N + EV_QA + 64 * (n15 & 7) + 8 * kg; qb0 = *(const bf16x8*)qp; qb1 = *(const bf16x8*)(qp + 32); }
        f32x4 S[16];
        u32x4 vv[16];
#pragma unroll
        for (int bt = 0; bt < 4; ++bt) {
            bf16x8 ka0[4], ka1[4];
#pragma unroll
            for (int t4 = 0; t4 < 4; ++t4) { const int pos = 16 * (4 * bt + t4) + n15; const int kidx = (pos < nsel) ? (int)sel[ql * 256 + pos] : 0;
                const bf16_t* kp = proj + (rowb + kidx) * EVEN_N + EV_KA + 8 * kg; ka0[t4] = *(const bf16x8*)kp; ka1[t4] = *(const bf16x8*)(kp + 32); }
#pragma unroll
            for (int t4 = 0; t4 < 4; ++t4) { const int tl = 4 * bt + t4;
                f32x4 acc = (f32x4){0.f, 0.f, 0.f, 0.f}; acc = MFMA16(ka0[t4], qb0, acc); acc = MFMA16(ka1[t4], qb1, acc);
#pragma unroll
                for (int i = 0; i < 4; ++i) S[tl][i] = (16 * tl + 4 * kg + i < nsel) ? acc[i] : -1e30f; }
            __builtin_amdgcn_sched_barrier(0);
        }
#pragma unroll
        for (int i = 0; i < 16; ++i) { const int e = lane2 + 64 * i, rho = e >> 3, ch = e & 7; const int kidx = (rho < nsel) ? (int)sel[ql * 256 + rho] : 0;
            vv[i] = *(const u32x4*)(proj + (rowb + kidx) * EVEN_N + EV_VA + 8 * ch); }
        float mx = -1e30f;
#pragma unroll
        for (int tl = 0; tl < 16; ++tl) mx = fmaxf(fmaxf(fmaxf(mx, S[tl][0]), fmaxf(S[tl][1], S[tl][2])), S[tl][3]);
        mx = fmaxf(mx, __shfl_xor(mx, 16)); mx = fmaxf(mx, __shfl_xor(mx, 32));
        float sum = 0.f;
#pragma unroll
        for (int tl = 0; tl < 16; ++tl)
#pragma unroll
            for (int i = 0; i < 4; ++i) { const float e = __builtin_amdgcn_exp2f(S[tl][i] - mx); S[tl][i] = e; sum += e; }
        sum += __shfl_xor(sum, 16); sum += __shfl_xor(sum, 32);
        const float inv = 1.0f / sum;
        f32x4 oacc[4];
#pragma unroll
        for (int dt = 0; dt < 4; ++dt) oacc[dt] = (f32x4){0.f, 0.f, 0.f, 0.f};
#pragma unroll
        for (int hh = 0; hh < 2; ++hh) {
#pragma unroll
            for (int i = 0; i < 16; ++i) { const int e = lane2 + 64 * i, rho = e >> 3, ch = e & 7;
                *(LAS u32x4*)(vst + rho * 128 + 16 * (ch ^ (((rho >> 1) & 3) << 1))) = vv[i]; }
            if (hh == 0) {
#pragma unroll
                for (int i = 0; i < 16; ++i) { const int e = lane2 + 64 * i, rho = e >> 3, ch = e & 7, pos = 128 + rho; const int kidx = (pos < nsel) ? (int)sel[ql * 256 + pos] : 0;
                    vv[i] = *(const u32x4*)(proj + (rowb + kidx) * EVEN_N + EV_VA + 8 * ch); }
            }
#pragma unroll
            for (int mm = 0; mm < 4; ++mm) { const int ms = 4 * hh + mm;
                const bf16x8 pa = pack8(S[2 * ms][0], S[2 * ms][1], S[2 * ms][2], S[2 * ms][3], S[2 * ms + 1][0], S[2 * ms + 1][1], S[2 * ms + 1][2], S[2 * ms + 1][3]);
#pragma unroll
                for (int dt = 0; dt < 4; ++dt) { const int rho = 32 * mm + 4 * kg + qq, ch = 2 * dt + (pp_ >> 1);
                    const s16x4 lo = vtr(vst + rho * 128 + 16 * (ch ^ (((rho >> 1) & 3) << 1)) + 8 * (pp_ & 1));
                    const s16x4 h4 = vtr(vst + (rho + 16) * 128 + 16 * (ch ^ ((((rho + 16) >> 1) & 3) << 1)) + 8 * (pp_ & 1));
                    const bf16x8 bv = (bf16x8){lo[0], lo[1], lo[2], lo[3], h4[0], h4[1], h4[2], h4[3]};
                    oacc[dt] = MFMA16(pa, bv, oacc[dt]); } }
        }
#pragma unroll
        for (int i = 0; i < 4; ++i) { const float il = __shfl(inv, (4 * kg + i) & 7);
            if (kg < 2) { bf16_t* op = merged + (rowb + t) * D + 64 * (4 * kg + i) + n15;
#pragma unroll
                for (int dt = 0; dt < 4; ++dt) op[16 * dt] = (bf16_t)(cvtpk_c(oacc[dt][i] * il, 0.f) & 0xffffu); } }
    }
    }
    __syncthreads();
}

enum { TK_PLAIN = 0, TK_SWIGLU = 1, TK_EVEN = 2, TK_ODD = 3 };
__device__ __forceinline__ int evencol(int G) {
    if (G < 8) return 64 * G; if (G < 16) return 640 + 64 * (G - 8); if (G < 24) return 1224 + 64 * (G - 16); if (G < 32) return 1736 + 64 * (G - 24);
    if (G == 32) return 512; if (G == 33) return 1152; if (G == 34) return 576; if (G == 35) return 1216; return 2248 + 64 * (G - 36);
}
__device__ __forceinline__ void transpose_item(const float* W0, const float* W1, const float* gain, int K, int Nsrc, int Ndst, bf16_t* WT, int kind, LAS float* scr, int item, int lane) {
    const int nblk = Ndst / 32, kb = item / nblk, nb = item % nblk, k0 = 64 * kb, n0 = 32 * nb;
    const float* src = W0; int col0 = n0, nvalid = 32;
    if (kind == TK_SWIGLU) { const int pn = n0 >> 8, bj = (n0 >> 7) & 1, y0 = n0 & 127; src = bj ? W1 : W0; col0 = 128 * pn + y0; }
    else if (kind == TK_EVEN) { const int pn = n0 >> 8, bj = (n0 >> 7) & 1, wc = (n0 >> 5) & 3, G = 4 * pn + wc; col0 = evencol(G) + 32 * bj; if (G == 35) nvalid = bj ? 0 : 8; }
    else if (kind == TK_ODD) { const int pn = n0 >> 8, bj = (n0 >> 7) & 1, wc = (n0 >> 5) & 3; col0 = 256 * pn + 64 * wc + 32 * bj; }
    const int ln = lane & 31;
    { float vv[32]; const float* sp = src + (size_t)(k0 + (lane >> 5)) * Nsrc + col0 + ln; const bool ok = ln < nvalid;
#pragma unroll
      for (int i = 0; i < 32; ++i) { vv[i] = ok ? *sp : 0.f; sp += 2 * Nsrc; asm volatile("" : "+v"(sp)); }
#pragma unroll
      for (int i = 0; i < 32; ++i) scr[(2 * i + (lane >> 5)) * 33 + ln] = vv[i]; }
    asm volatile("s_waitcnt lgkmcnt(0)" ::: "memory");
    const int c = lane & 7;
    f32x4 g0 = (f32x4){1.f, 1.f, 1.f, 1.f}, g1 = g0;
    if (gain) { g0 = *(const f32x4*)(gain + k0 + 8 * c); g1 = *(const f32x4*)(gain + k0 + 8 * c + 4); }
#pragma unroll
    for (int j = 0; j < 4; ++j) { const int n = (lane >> 3) + 8 * j; const LAS float* s = scr + (8 * c) * 33 + n;
        u32x4 o; o.x = cvt_pk_bf16(s[0 * 33] * g0[0], s[1 * 33] * g0[1]); o.y = cvt_pk_bf16(s[2 * 33] * g0[2], s[3 * 33] * g0[3]); o.z = cvt_pk_bf16(s[4 * 33] * g1[0], s[5 * 33] * g1[1]); o.w = cvt_pk_bf16(s[6 * 33] * g1[2], s[7 * 33] * g1[3]);
        *(u32x4*)(WT + (size_t)(n0 + n) * K + k0 + 8 * c) = o; }
    asm volatile("s_waitcnt lgkmcnt(0)" ::: "memory");
}

struct Args { const float* in[24]; float* out; unsigned char* ws; int ph_lo, ph_hi; };

__device__ __forceinline__ void prep_phase(const Args& a, LAS unsigned char* lds, int tid, int wid, int lane) {
    unsigned char* ws = a.ws;
    const int gw = blockIdx.x * NWAVES + wid, NGW = gridDim.x * NWAVES;
    const int gt = blockIdx.x * NTHR + tid, NGT = gridDim.x * NTHR;
    LAS float* scr = (LAS float*)(lds + wid * 16384);
    int base = 0;
    for (int job = 0; job < 16; ++job) {
        const float *W0 = nullptr, *W1 = nullptr, *gain = nullptr; bf16_t* dst = nullptr; int K = 1024, Nsrc = 1024, Ndst = 1024, kind = TK_PLAIN;
        if (job < 12) { const int l = job / 6, k = job % 6; const size_t fb = (l ? WS_FFN1 : WS_FFN0);
            if (k == 0) { W0 = a.in[3] + (size_t)l * D * FF; W1 = a.in[4] + (size_t)l * D * FF; gain = a.in[2] + l * D; dst = (bf16_t*)(ws + fb); Nsrc = FF; Ndst = NGU; kind = TK_SWIGLU; }
            else if (k == 1) { W0 = a.in[5] + (size_t)l * FF * D; dst = (bf16_t*)(ws + fb + SZ_GU); K = FF; }
            else if (k == 2) { W0 = a.in[8] + (size_t)l * D * FF; W1 = a.in[9] + (size_t)l * D * FF; gain = a.in[7] + l * D; dst = (bf16_t*)(ws + fb + SZ_GU + SZ_WD); Nsrc = FF; Ndst = NGU; kind = TK_SWIGLU; }
            else if (k == 3) { W0 = a.in[10] + (size_t)l * FF * D; dst = (bf16_t*)(ws + fb + 2 * SZ_GU + SZ_WD); K = FF; }
            else if (k == 4) { W0 = a.in[12] + (size_t)l * D * D; gain = a.in[11] + l * D; dst = (bf16_t*)(ws + WS_PG + (size_t)l * D * D * 2); }
            else { W0 = a.in[13] + (size_t)l * PLE * D; dst = (bf16_t*)(ws + WS_PP + (size_t)l * D * PLE * 2); K = PLE; }
        } else if (job == 12) { W0 = a.in[14]; gain = a.in[6]; dst = (bf16_t*)(ws + WS_WIN_E); Nsrc = EVEN_SRC; Ndst = EVEN_N; kind = TK_EVEN; }
        else if (job == 13) { W0 = a.in[15]; dst = (bf16_t*)(ws + WS_WOUT_E); }
        else if (job == 14) { W0 = a.in[21]; gain = a.in[6] + D; dst = (bf16_t*)(ws + WS_WIN_O); Nsrc = ODD_N; Ndst = ODD_N; kind = TK_ODD; }
        else { W0 = a.in[22]; dst = (bf16_t*)(ws + WS_WOUT_O); }
        const int nitems = (K / 64) * (Ndst / 32);
        for (int it = (gw + NGW - (base % NGW)) % NGW; it < nitems; it += NGW) transpose_item(W0, W1, gain, K, Nsrc, Ndst, dst, kind, scr, it, lane);
        base += nitems;
    }
    { const float* x = a.in[0]; pg8::ssq_t* ssq = (pg8::ssq_t*)(ws + WS_SSQ); bf16_t* hb = (bf16_t*)(ws + WS_HBA);
      for (int r = gw; r < M; r += 2 * NGW) { const int r2 = (r + NGW < M) ? r + NGW : r;
          const f32x4* xr = (const f32x4*)(x + (size_t)r * D) + lane; const f32x4* xr2 = (const f32x4*)(x + (size_t)r2 * D) + lane; f32x4 v[4], v2[4];
#pragma unroll
          for (int j = 0; j < 4; ++j) { v[j] = xr[64 * j]; v2[j] = xr2[64 * j]; }
          u32x2* br = (u32x2*)(hb + (size_t)r * D) + lane; u32x2* br2 = (u32x2*)(hb + (size_t)r2 * D) + lane; float s = 0.f, s2 = 0.f;
#pragma unroll
          for (int j = 0; j < 4; ++j) { u32x2 w; w.x = cvt_pk_bf16(v[j][0], v[j][1]); w.y = cvt_pk_bf16(v[j][2], v[j][3]); br[64 * j] = w; s += (v[j][0] * v[j][0] + v[j][1] * v[j][1]) + (v[j][2] * v[j][2] + v[j][3] * v[j][3]);
              w.x = cvt_pk_bf16(v2[j][0], v2[j][1]); w.y = cvt_pk_bf16(v2[j][2], v2[j][3]); br2[64 * j] = w; s2 += (v2[j][0] * v2[j][0] + v2[j][1] * v2[j][1]) + (v2[j][2] * v2[j][2] + v2[j][3] * v2[j][3]); }
          s = wave_sum(s); s2 = wave_sum(s2); if (lane == 0) { ssq[r] = (pg8::ssq_t)__float2ull_rn(s * pg8::SSQ_SCALE); ssq[r2] = (pg8::ssq_t)__float2ull_rn(s2 * pg8::SSQ_SCALE); } }
      for (int i = gt; i < 8 * M; i += NGT) ssq[M + i] = 0ull; }
    { const f32x4* p4 = (const f32x4*)a.in[1]; u32x2* o = (u32x2*)(ws + WS_PBF);
      for (int i = gt; i < 2 * M * PLE / 4; i += 4 * NGT) { f32x4 v[4];
#pragma unroll
          for (int j = 0; j < 4; ++j) v[j] = p4[i + j * NGT];
#pragma unroll
          for (int j = 0; j < 4; ++j) { u32x2 w; w.x = cvt_pk_bf16(v[j][0], v[j][1]); w.y = cvt_pk_bf16(v[j][2], v[j][3]); o[i + j * NGT] = w; } } }
    { float* cs = (float*)(ws + WS_COS); float* sn = (float*)(ws + WS_SIN);
      for (int i = gt; i < T * 32; i += NGT) { const int t = i >> 5, k = i & 31; const float inv = 1.0f / exp2f((float)k * (13.287712379549449f / 32.0f)); const float ang = (float)t * inv;
          float s, c; sincosf(ang, &s, &c); cs[i] = c; sn[i] = s; } }
}

#define XB_TMO      128
#define XB_XCNT(j)  (256  + 64 * (j))
#define XB_XSUB(j)  (1280 + 64 * (j))
#define XB_XGEN(j)  (2304 + 64 * (j))
#define XB_TOP      3328
#define XB_TOPGEN   3392
#define XCD_BAR_WORDS 3456
#define XB_SPIN_CAP (1u << 18)

__device__ __forceinline__ unsigned xb_ld(unsigned* p)              { return __hip_atomic_load(p, __ATOMIC_RELAXED, __HIP_MEMORY_SCOPE_AGENT); }
__device__ __forceinline__ unsigned xb_add(unsigned* p, unsigned v) { return __hip_atomic_fetch_add(p, v, __ATOMIC_RELAXED, __HIP_MEMORY_SCOPE_AGENT); }
__device__ __forceinline__ unsigned xb_xcc_id() { return (unsigned)__builtin_amdgcn_s_getreg((3 << 11) | 20) & 0xFu; }
#define XB_SPIN(cond, bar) do { unsigned _sp = 0; while (cond) { __builtin_amdgcn_s_sleep(1); \
    if ((++_sp & 255u) == 0u) { if (xb_ld(&(bar)[XB_TMO])) break; if (_sp > XB_SPIN_CAP) { atomicAdd(&(bar)[XB_TMO], 1u); break; } } } } while (0)

struct XcdBarrier {
    unsigned* bar; unsigned x;
    volatile LAS unsigned* st;
};

__device__ __forceinline__ XcdBarrier xcd_barrier_post(unsigned* bar, volatile LAS unsigned* st) {
    XcdBarrier b; b.bar = bar; b.x = xb_xcc_id(); b.st = st;
    if (threadIdx.x == 0) (void)xb_add(&bar[XB_XCNT(b.x)], 1u);
    return b;
}
__device__ __forceinline__ void xcd_barrier_complete(unsigned* bar, unsigned x, unsigned& nloc, unsigned& nx) {
    const unsigned G = gridDim.x * gridDim.y * gridDim.z;
    unsigned sum, cnt, mine, sp = 0u;
    for (;;) {
        sum = 0u; cnt = 0u; mine = 0u;
#pragma unroll
        for (unsigned j = 0; j < 16; ++j) { const unsigned c = xb_ld(&bar[XB_XCNT(j)]); sum += c; cnt += (c > 0u) ? 1u : 0u; mine = (j == x) ? c : mine; }
        if (sum == G) break;
        __builtin_amdgcn_s_sleep(1);
        if ((++sp & 255u) == 0u) { if (xb_ld(&bar[XB_TMO])) break; if (sp > XB_SPIN_CAP) { atomicAdd(&bar[XB_TMO], 1u); break; } }
    }
    nloc = mine > 0u ? mine : 1u; nx = cnt > 0u ? cnt : 1u;
}

__device__ __forceinline__ void xcd_barrier(const XcdBarrier& b) {
    asm volatile("s_waitcnt vmcnt(0)" ::: "memory");
    __syncthreads();
    if (threadIdx.x == 0) {
        unsigned* bar = b.bar;
        __builtin_amdgcn_s_waitcnt(0);
        unsigned nloc = b.st[0], nx = b.st[1];
        if (nloc == 0u) { xcd_barrier_complete(bar, b.x, nloc, nx); b.st[0] = nloc; b.st[1] = nx; }
        const unsigned old = xb_add(&bar[XB_XSUB(b.x)], 1u);
        const unsigned gen = old / nloc;
        if (old + 1u == (gen + 1u) * nloc) {
            __builtin_amdgcn_fence(__ATOMIC_RELEASE, "agent");
            asm volatile("s_waitcnt vmcnt(0)" ::: "memory");
            const unsigned og = xb_add(&bar[XB_TOP], 1u);
            const unsigned tg = og / nx;
            if (og + 1u == (tg + 1u) * nx) xb_add(&bar[XB_TOPGEN], 1u);
            else XB_SPIN(xb_ld(&bar[XB_TOPGEN]) == tg, bar);
            __builtin_amdgcn_fence(__ATOMIC_ACQUIRE, "agent");
            xb_add(&bar[XB_XGEN(b.x)], 1u);
            asm volatile("s_waitcnt vmcnt(0)" ::: "memory");
        } else {
            XB_SPIN(xb_ld(&bar[XB_XGEN(b.x)]) == gen, bar);
            __builtin_amdgcn_fence(__ATOMIC_ACQUIRE, "agent");
            asm volatile("s_waitcnt vmcnt(0)" ::: "memory");
        }
    }
    __syncthreads();
}

#define XL_SUB(j) (3584 + 64 * (j))
#define XL_GEN(j) (4608 + 64 * (j))
__device__ __forceinline__ void xcd_local_barrier(const XcdBarrier& b) {
    asm volatile("s_waitcnt vmcnt(0)" ::: "memory");
    __syncthreads();
    if (threadIdx.x == 0) {
        unsigned* bar = b.bar;
        __builtin_amdgcn_s_waitcnt(0);
        const unsigned nloc = b.st[0];
        const unsigned old = xb_add(&bar[XL_SUB(b.x)], 1u);
        const unsigned gen = old / nloc;
        if (old + 1u == (gen + 1u) * nloc) xb_add(&bar[XL_GEN(b.x)], 1u);
        else XB_SPIN(xb_ld(&bar[XL_GEN(b.x)]) == gen, bar);
        __builtin_amdgcn_fence(__ATOMIC_ACQUIRE, "agent");
        asm volatile("s_waitcnt vmcnt(0)" ::: "memory");
    }
    __syncthreads();
}

struct PpOrder { pg8::StaticOrder so; int xcc, rank; bool local;
    __device__ __forceinline__ bool next(int i, pg8::Unit& u) const { if (!local) return so.next(i, u); if (rank < 16 || i >= 2) return false; const int j = (rank - 16) * 2 + i; u.pm = 8 * xcc + (j & 7); u.pn = j >> 3; return true; }
    __device__ __forceinline__ void a_ready(const pg8::Unit&) const {}
    __device__ __forceinline__ void done(const pg8::Unit&) const {}
};
#define IN(k) (lo <= (k) && (k) < hi)
#define TIDS int tid = threadIdx.x; asm volatile("" : "+v"(tid)); const int lane = tid & 63, wid = __builtin_amdgcn_readfirstlane(tid >> 6)
#define SEAM(k) do { if (IN(k) && IN((k) + 1)) { if (local_ok) xcd_local_barrier(xbar); else xcd_barrier(xbar); } } while (0)
#define PTRS unsigned char* ws = a.ws; asm volatile("" : "+s"(ws)); pg8::ssq_t* ssq = (pg8::ssq_t*)(ws + WS_SSQ); float* h = a.out; \
    bf16_t* hbA = (bf16_t*)(ws + WS_HBA); bf16_t* hbB = (bf16_t*)(ws + WS_HBB); bf16_t* big = (bf16_t*)(ws + WS_BIG); bf16_t* mrg = (bf16_t*)(ws + WS_MRG); \
    (void)ssq; (void)h; (void)hbA; (void)hbB; (void)big; (void)mrg
#define GEMM_SWIGLU(L, SECOND) do { PTRS; \
    pg8::Gemm g{(SECOND) ? hbA : ((L) == 0 ? hbA : hbB), (const bf16_t*)(ws + ((L) ? WS_FFN1 : WS_FFN0) + ((SECOND) ? SZ_GU + SZ_WD : 0)), M, NGU, D}; pg8::StaticOrder S; S.init(M, NGU, G, c); \
    pg8::EpiSwiglu E{big, ssq + (size_t)(4 * (L) + ((SECOND) ? 2 : 0)) * M}; \
    pg8::gemm_phase<pg8::EpiSwiglu, pg8::StaticOrder, true, true>(lds, g, S, E); } while (0)
#define GEMM_RESID(A_, BT_, K_, SSQI, SC, HIN) do { PTRS; \
    pg8::Gemm g{(A_), (const bf16_t*)(ws + (BT_)), M, D, (K_)}; pg8::StaticOrder S; S.init(M, D, G, c); \
    pg8::EpiResid E{(HIN), h, hbA, ssq + (size_t)(SSQI) * M, (SC)}; \
    pg8::gemm_phase<pg8::EpiResid, pg8::StaticOrder, true, true>(lds, g, S, E); } while (0)
#define LAYER(L) do { const int k0 = 1 + 8 * (L); \
    if (IN(k0 + 0) && PHON(1)) for (int rep = 0; rep < REP_SWI; ++rep) GEMM_SWIGLU(L, 0); \
    SEAM(k0 + 0); \
    if (IN(k0 + 1) && PHON(2)) GEMM_RESID(big, ((L) ? WS_FFN1 : WS_FFN0) + SZ_GU, FF, 4 * (L) + 1, 0.5f, ((L) == 0 ? a.in[0] : (const float*)h)); \
    SEAM(k0 + 1); \
    if (IN(k0 + 2) && PHON(3)) { PTRS; constexpr int N = ((L) == 0) ? EVEN_N : ODD_N; \
        pg8::Gemm g{hbA, (const bf16_t*)(ws + ((L) == 0 ? WS_WIN_E : WS_WIN_O)), M, N, D}; pg8::StaticOrder S; S.init(M, N, G, c); \
        pg8::EpiProj E{big, N, ssq + (size_t)(4 * (L) + 1) * M, (const float*)(ws + WS_COS), (const float*)(ws + WS_SIN), ((L) == 0) ? 0x3FFFFFFFFull : 0xFFFFFFFFull, ((L) == 0) ? 0x00FF00FFull : 0xFFFFull}; \
        pg8::gemm_phase<pg8::EpiProj, pg8::StaticOrder, true, true>(lds, g, S, E); } \
    SEAM(k0 + 2); \
    if (IN(k0 + 3)) { PTRS; \
        if ((L) == 0) { \
            if (PHON(4)) for (int rep = 0; rep < REP_DSA; ++rep) { TIDS; for (int j = 0; j < 4; ++j) { const int rk = c >> 3; dsa_unit(lds, big, mrg, c & 7, (j == 0) ? rk : (j == 1) ? 63 - rk : (j == 2) ? 64 + rk : 127 - rk, tid, wid, lane); } } \
            if (PHON(5)) { TIDS; float lam; { const float s1 = wave_sum(a.in[16][lane] * a.in[17][lane]), s2 = wave_sum(a.in[18][lane] * a.in[19][lane]); lam = expf(s1) - expf(s2) + 0.2f; } \
                for (int rep = 0; rep < REP_DIFF; ++rep) { const int b = c & 7, hb = (c >> 6) & 3, s = (c >> 3) & 7; \
                    diff_unit(lds, big, mrg, a.in[20], lam, b, hb, 15 - s, tid, wid, lane); \
                    diff_unit(lds, big, mrg, a.in[20], lam, b, hb, s, tid, wid, lane); } } \
        } else { \
            if (PHON(6)) for (int rep = 0; rep < REP_DIL; ++rep) { TIDS; for (int j = 0; j < 2; ++j) { const int b = c & 7, hp = ((c >> 6) & 3) + 4 * j, s = (c >> 3) & 7; \
                dil_unit(lds, big, mrg, b, hp, 15 - s, tid, wid, lane); __syncthreads(); \
                dil_unit(lds, big, mrg, b, hp, s, tid, wid, lane); __syncthreads(); } } \
        } } \
    SEAM(k0 + 3); \
    if (IN(k0 + 4) && PHON(2)) GEMM_RESID(mrg, ((L) == 0 ? WS_WOUT_E : WS_WOUT_O), D, 4 * (L) + 2, 1.0f, (const float*)h); \
    SEAM(k0 + 4); \
    if (IN(k0 + 5)) { if (PHON(1)) GEMM_SWIGLU(L, 1); \
        if (PHON(8)) { PTRS; pg8::Gemm g2{(const bf16_t*)(ws + WS_PBF) + (size_t)(L) * M * PLE, (const bf16_t*)(ws + WS_PP) + (size_t)(L) * D * PLE, M, D, PLE}; pg8::StaticOrder S2; S2.init(M, D, G, c); \
            pg8::EpiPlain E2{mrg, D}; PpOrder S3{S2, c & 7, c >> 3, local_ok}; pg8::gemm_phase<pg8::EpiPlain, PpOrder, true, true>(lds, g2, S3, E2); } } \
    SEAM(k0 + 5); \
    if (IN(k0 + 6) && PHON(2)) GEMM_RESID(big, ((L) ? WS_FFN1 : WS_FFN0) + 2 * SZ_GU + SZ_WD, FF, 4 * (L) + 3, 0.5f, (const float*)h); \
    SEAM(k0 + 6); \
    if (IN(k0 + 7) && PHON(7)) { PTRS; pg8::Gemm g{hbA, (const bf16_t*)(ws + WS_PG) + (size_t)(L) * D * D, M, D, D}; pg8::StaticOrder S; S.init(M, D, G, c); \
        pg8::EpiPle E{h, hbB, mrg, ssq + (size_t)(4 * (L) + 3) * M, ssq + (size_t)(4 * (L) + 4) * M}; \
        pg8::gemm_phase<pg8::EpiPle, pg8::StaticOrder, true, true>(lds, g, S, E); } \
    SEAM(k0 + 7); } while (0)

__global__ void __launch_bounds__(NTHR, 2) mega_fwd(Args a) {
    extern __shared__ __attribute__((aligned(16))) unsigned char lds_raw[];
    LAS unsigned char* lds = (LAS unsigned char*)lds_raw;
    cg::grid_group grid = cg::this_grid();
    const int G = gridDim.x;
    const int lo = a.ph_lo, hi = a.ph_hi;
    volatile LAS unsigned* MISC = (volatile LAS unsigned*)(lds + LDS_MISC);
    if (threadIdx.x < 64) MISC[threadIdx.x] = 0u;
    __syncthreads();
    XcdBarrier xbar; xbar.bar = (unsigned*)(a.ws + WS_BAR); xbar.x = xb_xcc_id(); xbar.st = MISC;
    if (threadIdx.x == 0) MISC[3] = xb_add(&xbar.bar[XB_XCNT(xbar.x)], 1u);
    for (int rep = 0; rep < REP_SYNC; ++rep) grid.sync();
    if (IN(0) && PHON(0)) for (int rep = 0; rep < REP_PREP; ++rep) { TIDS; prep_phase(a, lds, tid, wid, lane); }
    int c = blockIdx.x; bool local_ok = false;
    if (IN(0) && IN(1)) {
        if (lo != 0) grid.sync();
        else {
            asm volatile("s_waitcnt vmcnt(0)" ::: "memory"); __syncthreads();
            if (threadIdx.x == 0) { __builtin_amdgcn_fence(__ATOMIC_RELEASE, "agent"); asm volatile("s_waitcnt vmcnt(0)" ::: "memory"); }
            xcd_barrier(xbar);
        }
        if (threadIdx.x == 0) { unsigned okc = (G == 256) ? 1u : 0u, nx = 0u;
            for (unsigned j = 0; j < 16; ++j) { const unsigned cn = xb_ld(&xbar.bar[XB_XCNT(j)]); nx += cn > 0u ? 1u : 0u; if (cn != (j < 8u ? (unsigned)G / 8u : 0u)) okc = 0u; }
            const unsigned mine = xb_ld(&xbar.bar[XB_XCNT(xbar.x)]);
            MISC[0] = mine > 0u ? mine : 1u; MISC[1] = nx > 0u ? nx : 1u; MISC[4] = okc; }
        __syncthreads();
        local_ok = __builtin_amdgcn_readfirstlane(MISC[4]) != 0u;
        if (local_ok) c = (int)__builtin_amdgcn_readfirstlane(xbar.x + 8u * MISC[3]);
    }
    LAYER(0);
    LAYER(1);
    if (IN(17) && PHON(9)) { TIDS; PTRS;
        const float* fg = a.in[23]; const pg8::ssq_t* sq = ssq + 8 * M;
        for (int r = (c & 7) * T + (c >> 3) * NWAVES + wid; r < ((c & 7) + 1) * T; r += (G >> 3) * NWAVES) { const float ri = pg8::rinv_of(sq, r); f32x4* hr = (f32x4*)(h + (size_t)r * D) + lane; const f32x4* g4 = (const f32x4*)fg + lane;
#pragma unroll
            for (int j = 0; j < 4; ++j) hr[64 * j] = hr[64 * j] * ri * g4[64 * j]; }
    }
}

extern "C" void kernel_launch(void* const* d_in, const int* in_sizes, int n_in, void* d_out, int out_size, void* d_ws, size_t ws_size, hipStream_t stream) {
    static int grid = 0;
    if (grid == 0) {
        if (n_in != 24 || out_size != M * D || ws_size < WS_END) { fprintf(stderr, "kernel_launch: unexpected shapes: n_in %d out %d ws %zu (need %zu)\n", n_in, out_size, ws_size, (size_t)WS_END); grid = -1; return; }
        int dev = 0, cus = 0, per_cu = 0;
        hipGetDevice(&dev); hipDeviceGetAttribute(&cus, hipDeviceAttributeMultiprocessorCount, dev);
        if (hipFuncSetAttribute((const void*)mega_fwd, hipFuncAttributeMaxDynamicSharedMemorySize, LDS_BYTES) != hipSuccess) { fprintf(stderr, "kernel_launch: hipFuncSetAttribute failed\n"); grid = -1; return; }
        if (hipOccupancyMaxActiveBlocksPerMultiprocessor(&per_cu, (const void*)mega_fwd, NTHR, LDS_BYTES) != hipSuccess || per_cu < 1) { fprintf(stderr, "kernel_launch: occupancy query says %d blocks/CU\n", per_cu); per_cu = 1; }
        (void)hipGetLastError();
        grid = cus * 1;
        fprintf(stderr, "kernel_launch: grid %d (cus %d, per_cu %d)\n", grid, cus, per_cu);
    }
    if (grid < 0) return;
    if (hipMemsetAsync((char*)d_ws + WS_BAR, 0, BAR_BYTES, stream) != hipSuccess) { fprintf(stderr, "kernel_launch: memset failed\n"); return; }
    Args a{};
    for (int i = 0; i < 24; ++i) a.in[i] = (const float*)d_in[i];
    a.out = (float*)d_out; a.ws = (unsigned char*)d_ws;
#if MK_ONE_LAUNCH
    a.ph_lo = 0; a.ph_hi = 18;
    { void* args[] = {&a}; hipError_t e = hipLaunchCooperativeKernel((const void*)mega_fwd, dim3(grid), dim3(NTHR), args, LDS_BYTES, stream);
      if (e != hipSuccess) fprintf(stderr, "cooperative launch failed: %s\n", hipGetErrorString(e)); }
#else
    for (int ph = 0; ph < 18; ++ph) { a.ph_lo = ph; a.ph_hi = ph + 1; void* args[] = {&a};
        hipError_t e = hipLaunchCooperativeKernel((const void*)mega_fwd, dim3(grid), dim3(NTHR), args, LDS_BYTES, stream);
        if (e != hipSuccess) { fprintf(stderr, "launch %d failed: %s\n", ph, hipGetErrorString(e)); break; } }
#endif
}
```
